# Optimizing an MI355X kernel written in HIP

```python
import math
import jax, jax.numpy as jnp
from jax import lax
import numpy as np

D_MODEL = 1024
BATCH = 4
SEQ = 8192
DEPTH = 2

HG_HEADS = 4
HG_DK = 128
HG_DV = 128
HG_KW = HG_HEADS * HG_DK
HG_WIDTH = HG_HEADS * HG_DV
HG_CHUNK = 32
FX_HEADS = 4
FX_DH = 128
FX_WIDTH = FX_HEADS * FX_DH
Q_BLOCK = 128
ML_HEADS = 4
ML_DK = 128
ML_DV = 256
ML_KW = ML_HEADS * ML_DK
ML_WIDTH = ML_HEADS * ML_DV
ML_CONV = 4
ML_CHUNK = 64

N_AB = (DEPTH + 1) // 2
N_C = DEPTH // 2
ALPHA = (2 * DEPTH) ** 0.25
BETA = (8 * DEPTH) ** -0.25
LN_EPS = 1e-5
RMS_EPS = 1e-6

AB_SIZES = [HG_KW, HG_KW, HG_WIDTH, HG_WIDTH, FX_WIDTH, FX_WIDTH, FX_WIDTH, FX_HEADS, FX_WIDTH]
AB_VALUE_SLOTS = (2, 6)
AB_COLS = sum(AB_SIZES)
C_SIZES = [ML_KW, ML_KW, ML_WIDTH, ML_HEADS, ML_HEADS, ML_WIDTH, ML_WIDTH]
C_VALUE_SLOTS = (2,)
C_COLS = sum(C_SIZES)
AB_OUT_IN = HG_WIDTH + FX_WIDTH

kernel_name = "hybrid_hgrn2_fox_mlstm_deepnorm"


def _split(h, sizes):
    idx = np.cumsum(sizes)[:-1].tolist()
    return jnp.split(h, idx, axis=-1)


def _to_chunks(t, n_heads, d, L):
    B, S, _ = t.shape
    return t.reshape(B, S // L, L, n_heads, d).transpose(1, 0, 3, 2, 4)


def _gate_chunks(t, L):
    B, S, H = t.shape
    return t.reshape(B, S // L, L, H).transpose(1, 0, 3, 2)


def _from_chunks(t):
    NC, B, H, L, d = t.shape
    return t.transpose(1, 0, 3, 2, 4).reshape(B, NC * L, H * d)


def _rmsnorm_heads(t, n_heads, g):
    B, S, W = t.shape
    th = t.reshape(B, S, n_heads, W // n_heads)
    th = th * lax.rsqrt(jnp.mean(th * th, axis=-1, keepdims=True) + RMS_EPS)
    return th.reshape(B, S, W) * g.astype(jnp.float32)


def _layernorm(t, g, b):
    mu = jnp.mean(t, axis=-1, keepdims=True)
    var = jnp.mean(jnp.square(t - mu), axis=-1, keepdims=True)
    return (t - mu) * lax.rsqrt(var + LN_EPS) * g.astype(jnp.float32) + b.astype(jnp.float32)


def _hgrn2_mix(q, f_logit, v, lb):
    B = q.shape[0]
    f = lb + (1.0 - lb) * jax.nn.sigmoid(f_logit)
    log_f = jnp.log(f)
    k = 1.0 - f
    qc = _to_chunks(q, HG_HEADS, HG_DK, HG_CHUNK)
    kc = _to_chunks(k, HG_HEADS, HG_DK, HG_CHUNK)
    gc = _to_chunks(log_f, HG_HEADS, HG_DK, HG_CHUNK)
    vc = _to_chunks(v, HG_HEADS, HG_DV, HG_CHUNK)
    mask = jnp.tril(jnp.ones((HG_CHUNK, HG_CHUNK), dtype=bool))

    def step(state, inp):
        qb, kb, vb, gb = inp
        b = jnp.cumsum(gb, axis=2)
        q_dec = qb * jnp.exp(b)
        k_inv = kb * jnp.exp(-b)
        a = jnp.where(mask, jnp.einsum('bhtk,bhsk->bhts', q_dec, k_inv), 0.0)
        o = jnp.einsum('bhts,bhsv->bhtv', a, vb) + jnp.einsum('bhtk,bhkv->bhtv', q_dec, state)
        b_last = b[:, :, -1:, :]
        k_end = kb * jnp.exp(b_last - b)
        new_state = jnp.exp(b_last[:, :, 0, :])[..., None] * state + jnp.einsum('bhsk,bhsv->bhkv', k_end, vb)
        return new_state, o

    s0 = jnp.zeros((B, HG_HEADS, HG_DK, HG_DV), jnp.float32)
    _, o = lax.scan(step, s0, (qc, kc, vc, gc))
    return _from_chunks(o)


def _fox_mix(q, k, v, f_logit, b_f):
    B, S, _ = q.shape
    log_f = jax.nn.log_sigmoid(f_logit + b_f.astype(jnp.float32))
    c = jnp.cumsum(log_f, axis=1).transpose(0, 2, 1)
    scale = FX_DH ** -0.5
    qh = q.reshape(B, S, FX_HEADS, FX_DH).transpose(0, 2, 1, 3) * scale
    kh = k.reshape(B, S, FX_HEADS, FX_DH).transpose(0, 2, 1, 3)
    vh = v.reshape(B, S, FX_HEADS, FX_DH).transpose(0, 2, 1, 3)
    n_blk = S // Q_BLOCK
    q_blocks = qh.reshape(B, FX_HEADS, n_blk, Q_BLOCK, FX_DH).transpose(2, 0, 1, 3, 4)
    c_blocks = c.reshape(B, FX_HEADS, n_blk, Q_BLOCK).transpose(2, 0, 1, 3)
    key_pos = jnp.arange(S)

    def block(args):
        qb, cb, i = args
        s = jnp.einsum('bhtd,bhsd->bhts', qb, kh) + cb[..., :, None] - c[:, :, None, :]
        q_pos = i * Q_BLOCK + jnp.arange(Q_BLOCK)
        s = jnp.where(key_pos[None, :] <= q_pos[:, None], s, -jnp.inf)
        p = jax.nn.softmax(s, axis=-1)
        return jnp.einsum('bhts,bhsd->bhtd', p, vh)

    out = lax.map(block, (q_blocks, c_blocks, jnp.arange(n_blk)))
    return out.transpose(1, 2, 0, 3, 4).reshape(B, FX_HEADS, S, FX_DH).transpose(0, 2, 1, 3).reshape(B, S, FX_WIDTH)


def _causal_conv(u, w, b):
    C = u.shape[-1]
    out = lax.conv_general_dilated(u, w.astype(jnp.float32)[:, None, :], window_strides=(1,),
                                   padding=[(ML_CONV - 1, 0)], dimension_numbers=('NWC', 'WIO', 'NWC'),
                                   feature_group_count=C)
    return out + b.astype(jnp.float32)


def _mlstm_mix(q, k, v, i_pre, f_pre):
    B = q.shape[0]
    k = k * (ML_DK ** -0.5)
    qc = _to_chunks(q, ML_HEADS, ML_DK, ML_CHUNK)
    kc = _to_chunks(k, ML_HEADS, ML_DK, ML_CHUNK)
    vc = _to_chunks(v, ML_HEADS, ML_DV, ML_CHUNK)
    ic = _gate_chunks(i_pre, ML_CHUNK)
    gc = _gate_chunks(jax.nn.log_sigmoid(f_pre), ML_CHUNK)
    mask = jnp.tril(jnp.ones((ML_CHUNK, ML_CHUNK), dtype=bool))

    def step(carry, inp):
        Cm, n, m = carry
        qb, kb, vb, ib, gb = inp
        b = jnp.cumsum(gb, axis=-1)
        d = jnp.where(mask, b[..., :, None] - b[..., None, :] + ib[..., None, :], -jnp.inf)
        inter = b + m[..., None]
        m_t = jnp.maximum(inter, jnp.max(d, axis=-1))
        w = jnp.exp(d - m_t[..., None])
        s_inter = jnp.exp(inter - m_t)
        qk = jnp.einsum('bhtk,bhsk->bhts', qb, kb) * w
        num = jnp.einsum('bhts,bhsv->bhtv', qk, vb) + s_inter[..., None] * jnp.einsum('bhtk,bhkv->bhtv', qb, Cm)
        den = jnp.sum(qk, axis=-1) + s_inter * jnp.einsum('bhtk,bhk->bht', qb, n)
        h = num / jnp.maximum(jnp.abs(den), jnp.exp(-m_t))[..., None]
        b_last = b[..., -1]
        g_end = b_last[..., None] - b + ib
        m_new = jnp.maximum(b_last + m, jnp.max(g_end, axis=-1))
        wk = jnp.exp(g_end - m_new[..., None])
        decay = jnp.exp(b_last + m - m_new)
        C_new = decay[..., None, None] * Cm + jnp.einsum('bhs,bhsk,bhsv->bhkv', wk, kb, vb)
        n_new = decay[..., None] * n + jnp.einsum('bhs,bhsk->bhk', wk, kb)
        return (C_new, n_new, m_new), h

    carry0 = (jnp.zeros((B, ML_HEADS, ML_DK, ML_DV), jnp.float32),
              jnp.zeros((B, ML_HEADS, ML_DK), jnp.float32),
              jnp.zeros((B, ML_HEADS), jnp.float32))
    _, h = lax.scan(step, carry0, (qc, kc, vc, ic, gc))
    return _from_chunks(h)


def _ab_layer(x32, lb, w_in, fox_bf, hg_norm_g, w_out):
    h = jnp.einsum('bsd,dc->bsc', x32, w_in.astype(jnp.float32))
    hq, hf, hi, hz, fq, fk, fv, ff, fz = _split(h, AB_SIZES)
    hg = _hgrn2_mix(hq, hf, hi, lb)
    hg = _rmsnorm_heads(hg, HG_HEADS, hg_norm_g) * jax.nn.silu(hz)
    fx = _fox_mix(fq, fk, fv, ff, fox_bf) * jax.nn.silu(fz)
    return jnp.einsum('bsc,cd->bsd', jnp.concatenate([hg, fx], axis=-1), w_out.astype(jnp.float32))


def _c_layer(x32, w_in, conv_w, conv_b, b_i, b_f, norm_g, w_out):
    h = jnp.einsum('bsd,dc->bsc', x32, w_in.astype(jnp.float32))
    mq, mk, mv, mi, mf, mo, mz = _split(h, C_SIZES)
    qk = jax.nn.silu(_causal_conv(jnp.concatenate([mq, mk], axis=-1), conv_w, conv_b))
    mq, mk = jnp.split(qk, [ML_KW], axis=-1)
    ht = _mlstm_mix(mq, mk, mv, mi + b_i.astype(jnp.float32), mf + b_f.astype(jnp.float32))
    ht = jax.nn.sigmoid(mo) * ht
    ht = _rmsnorm_heads(ht, ML_HEADS, norm_g) * jax.nn.silu(mz)
    return jnp.einsum('bsc,cd->bsd', ht, w_out.astype(jnp.float32))


def setup_inputs(seed: int = 0) -> dict:
    key = jax.random.key(seed)
    ks = jax.random.split(key, 16)
    f32 = jnp.float32

    def col_scale(sizes, slots):
        return jnp.concatenate([jnp.full((s,), BETA if j in slots else 1.0, f32) for j, s in enumerate(sizes)])

    x = jax.random.normal(ks[0], (BATCH, SEQ, D_MODEL), f32)
    hgrn_lb_logits = 1.0 + 0.1 * jax.random.normal(ks[1], (DEPTH + 1, HG_KW), f32)
    ab_w_in = jax.random.normal(ks[2], (N_AB, D_MODEL, AB_COLS), f32) * (D_MODEL ** -0.5) * col_scale(AB_SIZES, AB_VALUE_SLOTS)
    ab_fox_bf = 0.1 * jax.random.normal(ks[3], (N_AB, FX_HEADS), f32)
    ab_hgrn_norm_g = 1.0 + 0.02 * jax.random.normal(ks[4], (N_AB, HG_WIDTH), f32)
    ab_w_out = jax.random.normal(ks[5], (N_AB, AB_OUT_IN, D_MODEL), f32) * (AB_OUT_IN ** -0.5) * BETA
    c_w_in = jax.random.normal(ks[6], (N_C, D_MODEL, C_COLS), f32) * (D_MODEL ** -0.5) * col_scale(C_SIZES, C_VALUE_SLOTS)
    c_conv_w = jax.random.normal(ks[7], (N_C, ML_CONV, 2 * ML_KW), f32) * (ML_CONV ** -0.5)
    c_conv_b = 0.02 * jax.random.normal(ks[8], (N_C, 2 * ML_KW), f32)
    c_bi = 0.1 * jax.random.normal(ks[9], (N_C, ML_HEADS), f32)
    c_bf = jax.random.uniform(ks[10], (N_C, ML_HEADS), f32, 3.0, 6.0)
    c_norm_g = 1.0 + 0.02 * jax.random.normal(ks[11], (N_C, ML_WIDTH), f32)
    c_w_out = jax.random.normal(ks[12], (N_C, ML_WIDTH, D_MODEL), f32) * (ML_WIDTH ** -0.5) * BETA
    ln_g = 1.0 + 0.02 * jax.random.normal(ks[13], (DEPTH, D_MODEL), f32)
    ln_b = 0.02 * jax.random.normal(ks[14], (DEPTH, D_MODEL), f32)
    return {"x": x, "hgrn_lb_logits": hgrn_lb_logits, "ab_w_in": ab_w_in, "ab_fox_bf": ab_fox_bf,
            "ab_hgrn_norm_g": ab_hgrn_norm_g, "ab_w_out": ab_w_out, "c_w_in": c_w_in,
            "c_conv_w": c_conv_w, "c_conv_b": c_conv_b, "c_bi": c_bi, "c_bf": c_bf,
            "c_norm_g": c_norm_g, "c_w_out": c_w_out, "ln_g": ln_g, "ln_b": ln_b}


def reference(x, hgrn_lb_logits, ab_w_in, ab_fox_bf, ab_hgrn_norm_g, ab_w_out, c_w_in,
              c_conv_w, c_conv_b, c_bi, c_bf, c_norm_g, c_w_out, ln_g, ln_b):
    lb_table = jnp.cumsum(jax.nn.softmax(hgrn_lb_logits.astype(jnp.float32), axis=0), axis=0)
    h = x.astype(jnp.float32)
    for l in range(DEPTH):
        if l % 2 == 0:
            j = l // 2
            y = _ab_layer(h, lb_table[l], ab_w_in[j], ab_fox_bf[j], ab_hgrn_norm_g[j], ab_w_out[j])
        else:
            j = l // 2
            y = _c_layer(h, c_w_in[j], c_conv_w[j], c_conv_b[j], c_bi[j], c_bf[j], c_norm_g[j], c_w_out[j])
        h = _layernorm(ALPHA * h + y, ln_g[l], ln_b[l])
    return h.astype(x.dtype)
```

```cpp
#include <hip/hip_runtime.h>
#include <hip/hip_cooperative_groups.h>
#include <cstdio>
namespace cg = cooperative_groups;

#define DI __device__ __forceinline__
#define LAS __attribute__((address_space(3)))
typedef unsigned short u16;
typedef short bf16x8 __attribute__((ext_vector_type(8)));
typedef short s16x4 __attribute__((ext_vector_type(4)));
typedef float f32x2 __attribute__((ext_vector_type(2)));
typedef float f32x4 __attribute__((ext_vector_type(4)));
typedef float f32x16 __attribute__((ext_vector_type(16)));
typedef unsigned u32x2 __attribute__((ext_vector_type(2)));
typedef unsigned u32x4 __attribute__((ext_vector_type(4)));

constexpr int T = 32768, SEQ = 8192;
constexpr float ALPHA_RES = 1.4142135623730951f;
constexpr float QSCALE = 0.08838834764831845f;
constexpr size_t REG = (size_t)T * 512;
constexpr int LDS_BYTES = 163840;

struct Params {
    const float* x; const float* lb_logits; const float* ab_w_in; const float* ab_fox_bf; const float* ab_norm_g; const float* ab_w_out;
    const float* c_w_in; const float* c_conv_w; const float* c_conv_b; const float* c_bi; const float* c_bf; const float* c_norm_g; const float* c_w_out;
    const float* ln_g; const float* ln_b;
    float* out;
    u16* W0T; u16* W1T; u16* W0oT; u16* W1oT; u16* X16; u16* P; u16* M;
    float* LF; float* CS; float* IG; float* FG; float* LB; unsigned* QKM;
    float* HS; float* HD; float* MS; float* MN; float* MSC; float* MM;
    unsigned* bar; int never; int pad_;
};

DI unsigned pk2(float a, float b) {
    typedef __bf16 bf2 __attribute__((ext_vector_type(2)));
    f32x2 v = {a, b};
    bf2 r = __builtin_convertvector(v, bf2);
    return __builtin_bit_cast(unsigned, r);
}
DI u16 f2bf(float a) { return (u16)(pk2(a, 0.f) & 0xffffu); }
DI float bf2f(u16 b) { return __uint_as_float(((unsigned)b) << 16); }
DI float bflo(unsigned w) { return __uint_as_float(w << 16); }
DI float bfhi(unsigned w) { return __uint_as_float(w & 0xffff0000u); }
DI u16 f2h(float a) { _Float16 hh = (_Float16)a; return __builtin_bit_cast(u16, hh); }
DI float h2f(u16 b) { return (float)__builtin_bit_cast(_Float16, b); }
DI int crow(int reg, int h) { return (reg & 3) + 8 * (reg >> 2) + 4 * h; }
DI f32x16 zero16() { f32x16 z; _Pragma("unroll") for (int i = 0; i < 16; ++i) z[i] = 0.f; return z; }
template <int O> DI bf16x8 pack8(const f32x16& x) {
    u32x4 w = {pk2(x[O], x[O + 1]), pk2(x[O + 2], x[O + 3]), pk2(x[O + 4], x[O + 5]), pk2(x[O + 6], x[O + 7])};
    return __builtin_bit_cast(bf16x8, w);
}
DI bf16x8 join4(s16x4 lo, s16x4 hi) { return __builtin_shufflevector(lo, hi, 0, 1, 2, 3, 4, 5, 6, 7); }
#define MFMA32(a, b, c) __builtin_amdgcn_mfma_f32_32x32x16_bf16((a), (b), (c), 0, 0, 0)
DI float log_sigmoid(float x) { return fminf(x, 0.f) - log1pf(expf(-fabsf(x))); }
DI float frcp(float x) { return __builtin_amdgcn_rcpf(x); }
DI float sigmoidf_(float x) { return 1.f / (1.f + __expf(-x)); }
DI float siluf_(float x) { return x / (1.f + __expf(-x)); }
DI float silu_fast(float x) { return x * frcp(1.f + __expf(-x)); }
DI int lane_id_raw() { return (int)__builtin_amdgcn_mbcnt_hi(~0u, __builtin_amdgcn_mbcnt_lo(~0u, 0u)); }
template <int M> DI float xlane(float v) {
    if constexpr (M == 32) {
        const unsigned u = __float_as_uint(v);
        auto rr = __builtin_amdgcn_permlane32_swap(u, u, false, false);
        const bool hi = lane_id_raw() >= 32;
        return __uint_as_float(hi ? rr[0] : rr[1]);
    } else {
        return __int_as_float(__builtin_amdgcn_ds_swizzle(__float_as_int(v), (M << 10) | 0x1f));
    }
}
template <int M> DI float xsum(float v) {
    if constexpr (M == 32) {
        const unsigned u = __float_as_uint(v);
        auto rr = __builtin_amdgcn_permlane32_swap(u, u, false, false);
        return __uint_as_float(rr[0]) + __uint_as_float(rr[1]);
    } else return v + xlane<M>(v);
}
template <int M> DI float xmax(float v) {
    if constexpr (M == 32) {
        const unsigned u = __float_as_uint(v);
        auto rr = __builtin_amdgcn_permlane32_swap(u, u, false, false);
        return fmaxf(__uint_as_float(rr[0]), __uint_as_float(rr[1]));
    } else return fmaxf(v, xlane<M>(v));
}
template <int N> DI void wave_sum_n(float (&v)[N]) {
#pragma unroll
    for (int i = 0; i < N; ++i) v[i] = xsum<32>(v[i]);
#pragma unroll
    for (int i = 0; i < N; ++i) v[i] = xsum<16>(v[i]);
#pragma unroll
    for (int i = 0; i < N; ++i) v[i] = xsum<8>(v[i]);
#pragma unroll
    for (int i = 0; i < N; ++i) v[i] = xsum<4>(v[i]);
#pragma unroll
    for (int i = 0; i < N; ++i) v[i] = xsum<2>(v[i]);
#pragma unroll
    for (int i = 0; i < N; ++i) v[i] = xsum<1>(v[i]);
}
DI int ltid() { int t = threadIdx.x; asm volatile("" : "+v"(t)); return t; }
DI float wave_reduce16(const float (&d)[16], int lane) {
    const bool b5 = lane & 32, b4 = lane & 16, b3 = lane & 8, b2 = lane & 4;
    float a8[8];
#pragma unroll
    for (int i = 0; i < 8; ++i) { const float keep = b5 ? d[8 + i] : d[i], snd = b5 ? d[i] : d[8 + i]; a8[i] = keep + xlane<32>(snd); }
    float a4[4];
#pragma unroll
    for (int i = 0; i < 4; ++i) { const float keep = b4 ? a8[4 + i] : a8[i], snd = b4 ? a8[i] : a8[4 + i]; a4[i] = keep + xlane<16>(snd); }
    float a2[2];
#pragma unroll
    for (int i = 0; i < 2; ++i) { const float keep = b3 ? a4[2 + i] : a4[i], snd = b3 ? a4[i] : a4[2 + i]; a2[i] = keep + xlane<8>(snd); }
    float a1;
    { const float keep = b2 ? a2[1] : a2[0], snd = b2 ? a2[0] : a2[1]; a1 = keep + xlane<4>(snd); }
    a1 = xsum<2>(a1); a1 = xsum<1>(a1);
    return a1;
}
DI float wave_sum(float v) {
    v = xsum<32>(v); v = xsum<16>(v); v = xsum<8>(v); v = xsum<4>(v); v = xsum<2>(v); v = xsum<1>(v);
    return v;
}

namespace pg8 {
constexpr int BM = 256, BK = 64, HALF = 128, HTB = HALF * BK * 2, STAGE_BYTES = 8 * HTB, NXCD = 8, WGM = 8;
DI int lds_byte(int r, int c) { const int st = (r >> 4) * 2 + (c >> 5), rr = r & 15, cc = c & 31, ob = rr * 64 + cc * 2; return st * 1024 + (ob ^ (((ob >> 9) & 1) << 5)); }
DI void stage_rc(int b, int& R, int& C) { const int st = b / 1024, sb = b % 1024, swz = sb ^ (((sb >> 9) & 1) << 5); R = (st >> 1) * 16 + swz / 64; C = (st & 1) * 32 + (swz % 64) / 2; }
DI int perm32(int rho) { const int n = rho >> 4, i = rho & 15; return 8 * (i >> 2) + 4 * n + (i & 3); }
struct Unit { int pm, pn; };
struct Gemm { const u16* A; const u16* Bt; int M, N, K; };
struct StaticOrder {
    int nM, nN, nwg, G, c;
    DI void init(int M, int N, int G_, int c_) { nM = M / BM; nN = N / BM; nwg = nM * nN; G = G_; c = c_; }
    DI bool next(int i, Unit& u) const {
        const long L = (long)i * G + c; if (L >= nwg) return false;
        int wgid = (int)L; { const int q = nwg / NXCD, r = nwg % NXCD, xcd = wgid % NXCD, off = wgid / NXCD; wgid = (xcd < r ? xcd * (q + 1) : r * (q + 1) + (xcd - r) * q) + off; }
        const int nig = WGM * nN, gid = wgid / nig, fm = gid * WGM, gsz = (nM - fm) < WGM ? (nM - fm) : WGM;
        u.pm = fm + ((wgid % nig) % gsz); u.pn = (wgid % nig) / gsz; return true;
    }
};

template <class Epi>
DI void gemm_phase(LAS unsigned char* lds, const Gemm g, const StaticOrder& S, const Epi& E) {
    int tid = threadIdx.x; asm volatile("" : "+v"(tid));
    const int wid = __builtin_amdgcn_readfirstlane(tid >> 6), lane = tid & 63, wr = wid >> 2, wc = wid & 3, fr = lane & 15, fq = lane >> 4;
    const int K = g.K, nt = K / BK;
    unsigned voffA[2], voffB[2];
#pragma unroll
    for (int i = 0; i < 2; ++i) { int R, C; stage_rc(tid * 16 + i * 8192, R, C); const int Rb = Epi::PERM ? ((R & ~31) + perm32(R & 31)) : R;
        voffA[i] = (unsigned)(R * K + C) * 2u; voffB[i] = (unsigned)(Rb * K + C) * 2u; }
    const size_t kstep = (size_t)(BK * 2);
    const size_t hstep = (size_t)HALF * K * 2;
    const size_t tstep = 2 * hstep;
    const unsigned ldsw = (unsigned)wid * 1024u;
    const int aoff = lds_byte(wr * 64 + fr, fq * 8), boff = lds_byte(wc * 32 + fr, fq * 8);
#define PG8_SA(b, h) (((b) * 2 + (h)) * HTB)
#define PG8_SB(b, h) ((4 + (b) * 2 + (h)) * HTB)
#define PG8_STAGE(bufoff, gbase, voff) do { _Pragma("unroll") for (int _i = 0; _i < 2; ++_i) \
        __builtin_amdgcn_global_load_lds((const unsigned*)((const char*)(gbase) + (voff)[_i]), (LAS unsigned*)(lds + (bufoff) + ldsw + _i * 8192), 16, 0, 0); } while (0)
#define PG8_LDA(dst, b, h) do { _Pragma("unroll") for (int m = 0; m < 4; ++m) _Pragma("unroll") for (int k = 0; k < 2; ++k) dst[m][k] = *(const LAS bf16x8*)(lds + PG8_SA(b, h) + aoff + m * 2048 + k * 1024); } while (0)
#define PG8_LDB(dst, b, h) do { _Pragma("unroll") for (int n = 0; n < 2; ++n) _Pragma("unroll") for (int k = 0; k < 2; ++k) dst[n][k] = *(const LAS bf16x8*)(lds + PG8_SB(b, h) + boff + n * 2048 + k * 1024); } while (0)
#define PG8_MMA(ai, bj, At, Bt) do { __builtin_amdgcn_s_setprio(1); _Pragma("unroll") for (int m = 0; m < 4; ++m) _Pragma("unroll") for (int n = 0; n < 2; ++n) _Pragma("unroll") for (int k = 0; k < 2; ++k) \
        acc[ai][bj][m][n] = __builtin_amdgcn_mfma_f32_16x16x32_bf16(Bt[n][k], At[m][k], acc[ai][bj][m][n], 0, 0, 0); __builtin_amdgcn_s_setprio(0); } while (0)
#define PG8_WAIT_V(n) asm volatile("s_waitcnt vmcnt(" #n ")" ::: "memory")
#define PG8_WAIT_L(n) asm volatile("s_waitcnt lgkmcnt(" #n ")" ::: "memory")
#define PG8_BAR __builtin_amdgcn_s_barrier()
#define PG8_SCHED __builtin_amdgcn_sched_barrier(0)
    Unit cur, nxt; int ui = 0;
    if (!S.next(0, cur)) return;
    f32x4 acc[2][2][4][2];
#pragma unroll
    for (int a = 0; a < 2; ++a)
#pragma unroll
        for (int b = 0; b < 2; ++b)
#pragma unroll
            for (int m = 0; m < 4; ++m)
#pragma unroll
                for (int n = 0; n < 2; ++n) acc[a][b][m][n] = (f32x4){0.f, 0.f, 0.f, 0.f};
    bf16x8 At[4][2], B0[2][2], B1[2][2];
    const char* cA = (const char*)g.A + (size_t)cur.pm * tstep; const char* cB = (const char*)g.Bt + (size_t)cur.pn * tstep;
    PG8_STAGE(PG8_SB(0, 0), cB, voffB); PG8_STAGE(PG8_SA(0, 0), cA, voffA); PG8_STAGE(PG8_SB(0, 1), cB + hstep, voffB); PG8_STAGE(PG8_SA(0, 1), cA + hstep, voffA);
    if (wr == 1) PG8_BAR;
    PG8_WAIT_V(4); PG8_BAR;
    PG8_STAGE(PG8_SB(1, 0), cB + kstep, voffB); PG8_STAGE(PG8_SA(1, 0), cA + kstep, voffA); PG8_STAGE(PG8_SB(1, 1), cB + hstep + kstep, voffB);
    PG8_WAIT_V(6); PG8_BAR;
    for (;;) {
        const bool has_next = S.next(ui + 1, nxt);
        const char* nA = has_next ? (const char*)g.A + (size_t)nxt.pm * tstep : cA; const char* nB = has_next ? (const char*)g.Bt + (size_t)nxt.pn * tstep : cB;
        for (int t = 0; t < nt; t += 2) {
            const bool last = (t == nt - 2);
            const char* a1 = cA + (size_t)(t + 1) * kstep;
            const char* a2 = last ? nA : cA + (size_t)(t + 2) * kstep; const char* b2 = last ? nB : cB + (size_t)(t + 2) * kstep;
            const char* a3 = a2 + kstep; const char* b3 = b2 + kstep;
            PG8_LDB(B0, 0, 0); PG8_SCHED; PG8_LDA(At, 0, 0); PG8_STAGE(PG8_SA(1, 1), a1 + hstep, voffA);
            PG8_WAIT_L(8); PG8_BAR; PG8_WAIT_L(0); PG8_MMA(0, 0, At, B0); PG8_BAR; PG8_SCHED;
            PG8_LDB(B1, 0, 1); PG8_STAGE(PG8_SB(0, 0), b2, voffB);
            PG8_BAR; PG8_WAIT_L(0); PG8_MMA(0, 1, At, B1); PG8_BAR;
            PG8_LDA(At, 0, 1); PG8_STAGE(PG8_SA(0, 0), a2, voffA);
            PG8_BAR; PG8_WAIT_L(0); PG8_MMA(1, 0, At, B0); PG8_BAR; PG8_SCHED;
            PG8_STAGE(PG8_SB(0, 1), b2 + hstep, voffB);
            PG8_WAIT_V(6); PG8_BAR; PG8_MMA(1, 1, At, B1); PG8_BAR;
            PG8_LDB(B0, 1, 0); PG8_SCHED; PG8_LDA(At, 1, 0); PG8_STAGE(PG8_SA(0, 1), a2 + hstep, voffA);
            PG8_WAIT_L(8); PG8_BAR; PG8_WAIT_L(0); PG8_MMA(0, 0, At, B0); PG8_BAR; PG8_SCHED;
            PG8_LDB(B1, 1, 1); PG8_STAGE(PG8_SB(1, 0), b3, voffB);
            PG8_BAR; PG8_WAIT_L(0); PG8_MMA(0, 1, At, B1); PG8_BAR;
            PG8_LDA(At, 1, 1); PG8_STAGE(PG8_SA(1, 0), a3, voffA);
            PG8_BAR; PG8_WAIT_L(0); PG8_MMA(1, 0, At, B0); PG8_BAR; PG8_SCHED;
            PG8_STAGE(PG8_SB(1, 1), b3 + hstep, voffB);
            PG8_WAIT_V(6); PG8_BAR; PG8_MMA(1, 1, At, B1); PG8_BAR;
        }
        E(acc, cur, wr, wc, fr, fq);
        if (!has_next) break;
#pragma unroll
        for (int a = 0; a < 2; ++a)
#pragma unroll
            for (int b = 0; b < 2; ++b)
#pragma unroll
                for (int m = 0; m < 4; ++m)
#pragma unroll
                    for (int n = 0; n < 2; ++n) acc[a][b][m][n] = (f32x4){0.f, 0.f, 0.f, 0.f};
        cur = nxt; cA = nA; cB = nB; ++ui;
    }
    PG8_WAIT_V(0);
    if (wr == 0) PG8_BAR;
    PG8_BAR;
#undef PG8_SA
#undef PG8_SB
#undef PG8_STAGE
#undef PG8_LDA
#undef PG8_LDB
#undef PG8_MMA
#undef PG8_WAIT_V
#undef PG8_WAIT_L
#undef PG8_BAR
#undef PG8_SCHED
}
}

template <int MODE, int DV = 128, int TLc = 64, int NRM = 0>
DI void epi_store(const f32x4 (&acc)[2][2][4][2], u16* base, int ld, int row0, int col0, const float* lb, int head0, unsigned* qkm = nullptr) {
    float rmax[2] = {0.f, 0.f};
    f32x4 lbv[2][2];
    if (MODE == 1) {
#pragma unroll
        for (int bj = 0; bj < 2; ++bj) { lbv[bj][0] = *(const f32x4*)(lb + col0 + bj * 128); lbv[bj][1] = *(const f32x4*)(lb + col0 + bj * 128 + 4); }
    }
#pragma unroll
    for (int ai = 0; ai < 2; ++ai)
#pragma unroll
        for (int m = 0; m < 4; ++m) {
            const int row = row0 + ai * 128 + m * 16;
#pragma unroll
            for (int bj = 0; bj < 2; ++bj) {
                const int col = col0 + bj * 128;
                float v[8];
#pragma unroll
                for (int e = 0; e < 4; ++e) { v[e] = acc[ai][bj][m][0][e]; v[4 + e] = acc[ai][bj][m][1][e]; }
                if (MODE == 1) {
                    const f32x4 l0 = lbv[bj][0], l1 = lbv[bj][1];
#pragma unroll
                    for (int e = 0; e < 8; ++e) { const float l = e < 4 ? l0[e & 3] : l1[e & 3]; const float f = l + (1.f - l) * frcp(1.f + __expf(-v[e])); v[e] = __logf(f); }
                    u32x4 w;
                    w.x = (unsigned)f2h(v[0]) | ((unsigned)f2h(v[1]) << 16); w.y = (unsigned)f2h(v[2]) | ((unsigned)f2h(v[3]) << 16);
                    w.z = (unsigned)f2h(v[4]) | ((unsigned)f2h(v[5]) << 16); w.w = (unsigned)f2h(v[6]) | ((unsigned)f2h(v[7]) << 16);
                    *(u32x4*)(base + (size_t)row * ld + col) = w;
                } else if (MODE == 2) {
                    const int frl = row0 & 15;
                    const bool b0 = frl & 1, b1 = frl & 2, b2 = frl & 4;
                    const unsigned w0 = pk2(v[0], v[1]), w1 = pk2(v[2], v[3]), w2 = pk2(v[4], v[5]), w3 = pk2(v[6], v[7]);
                    const unsigned mine0 = b0 ? w2 : w0, mine1 = b0 ? w3 : w1, snd0 = b0 ? w0 : w2, snd1 = b0 ? w1 : w3;
                    const unsigned r0 = __float_as_uint(xlane<1>(__uint_as_float(snd0))), r1 = __float_as_uint(xlane<1>(__uint_as_float(snd1)));
                    unsigned E[4];
#pragma unroll
                    for (int i = 0; i < 4; ++i) {
                        const unsigned a = (i >> 1) ? mine1 : mine0, bq = (i >> 1) ? r1 : r0;
                        const unsigned ha = (i & 1) ? (a >> 16) : (a & 0xffffu), hb = (i & 1) ? (bq >> 16) : (bq & 0xffffu);
                        E[i] = b0 ? (hb | (ha << 16)) : (ha | (hb << 16));
                    }
                    const unsigned kE0 = b1 ? E[2] : E[0], kE1 = b1 ? E[3] : E[1], sE0 = b1 ? E[0] : E[2], sE1 = b1 ? E[1] : E[3];
                    const unsigned rE0 = __float_as_uint(xlane<2>(__uint_as_float(sE0))), rE1 = __float_as_uint(xlane<2>(__uint_as_float(sE1)));
                    const unsigned F0lo = b1 ? rE0 : kE0, F0hi = b1 ? kE0 : rE0, F1lo = b1 ? rE1 : kE1, F1hi = b1 ? kE1 : rE1;
                    const unsigned kFlo = b2 ? F1lo : F0lo, kFhi = b2 ? F1hi : F0hi, sFlo = b2 ? F0lo : F1lo, sFhi = b2 ? F0hi : F1hi;
                    const unsigned rFlo = __float_as_uint(xlane<4>(__uint_as_float(sFlo))), rFhi = __float_as_uint(xlane<4>(__uint_as_float(sFhi)));
                    u32x4 G;
                    G.x = b2 ? rFlo : kFlo; G.y = b2 ? rFhi : kFhi; G.z = b2 ? kFlo : rFlo; G.w = b2 ? kFhi : rFhi;
                    const int rowb = row - frl;
                    const int b = rowb >> 13, s = (rowb & (SEQ - 1)) + 8 * (frl >> 3);
                    const int cc = col + (b0 ? 4 : 0) + (b1 ? 2 : 0) + (b2 ? 1 : 0);
                    const int head = head0 + cc / DV, dv = cc % DV;
                    constexpr int TL = TLc;
                    u16* o = base + (((size_t)(b * 4 + head) * (SEQ / TL) + s / TL) * DV + dv) * TL + (s % TL);
                    *(u32x4*)o = G;
                } else {
#pragma unroll
                    for (int e = 0; e < 8; ++e) {
                        if (MODE == 3) v[e] = siluf_(v[e]);
                        if (MODE == 6) v[e] = v[e] * frcp(1.f + __expf(-v[e]));
                        if (MODE == 7) v[e] = frcp(1.f + __expf(-v[e]));
                        if (MODE == 4) v[e] *= QSCALE;
                        if (MODE == 5) v[e] = sigmoidf_(v[e]);
                    }
                    u32x4 w = {pk2(v[0], v[1]), pk2(v[2], v[3]), pk2(v[4], v[5]), pk2(v[6], v[7])};
                    __builtin_nontemporal_store(w, (u32x4*)(base + (size_t)row * ld + col));
                    if (NRM) {
                        float ssq = 0.f;
#pragma unroll
                        for (int e = 0; e < 4; ++e) { const float lo = bflo(w[e]), hi = bfhi(w[e]); ssq += lo * lo + hi * hi; }
                        ssq = xsum<16>(ssq); ssq = xsum<32>(ssq);
                        rmax[bj] = fmaxf(rmax[bj], ssq);
                    }
                }
            }
        }
    if (NRM) {
#pragma unroll
        for (int bj = 0; bj < 2; ++bj) {
            float mm = rmax[bj];
            mm = xmax<1>(mm); mm = xmax<2>(mm); mm = xmax<4>(mm); mm = xmax<8>(mm);
            if (lane_id_raw() == 0) {
                const int b = row0 >> 13, head = ((col0 >> 8) & 1) * 2 + bj, wcw = (col0 >> 5) & 3;
                atomicMax(qkm + ((b * 4 + head) * 4 + wcw), __float_as_uint(mm));
            }
        }
    }
}

struct EpiIn0 {
    static constexpr bool PERM = true;
    u16* P; const float* LB; unsigned* QKM;
    DI void operator()(const f32x4 (&acc)[2][2][4][2], const pg8::Unit& u, int wr, int wc, int fr, int fq) const {
        const int slot = u.pn >> 1;
        const int row0 = u.pm * 256 + wr * 64 + fr;
        const int col0 = (u.pn & 1) * 256 + wc * 32 + 8 * fq;
        u16* base = P + (size_t)slot * REG;
        switch (slot) {
            case 0: epi_store<0>(acc, base, 512, row0, col0, nullptr, 0); break;
            case 1: epi_store<1>(acc, base, 512, row0, col0, LB, 0); break;
            case 2: epi_store<2, 128, 32>(acc, base, 32, row0, col0, nullptr, 0); break;
            case 3: epi_store<6>(acc, base, 512, row0, col0, nullptr, 0); break;
            case 4: epi_store<4, 128, 64, 1>(acc, base, 512, row0, col0, nullptr, 0, QKM); break;
            case 5: epi_store<0, 128, 64, 1>(acc, base, 512, row0, col0, nullptr, 0, QKM + 64); break;
            case 6: epi_store<2, 128, 64>(acc, base, 64, row0, col0, nullptr, 0); break;
            default: epi_store<6>(acc, base, 512, row0, col0, nullptr, 0); break;
        }
    }
};
struct EpiIn1 {
    static constexpr bool PERM = true;
    u16* P;
    DI void operator()(const f32x4 (&acc)[2][2][4][2], const pg8::Unit& u, int wr, int wc, int fr, int fq) const {
        const int pn = u.pn;
        const int row0 = u.pm * 256 + wr * 64 + fr;
        const int cw = wc * 32 + 8 * fq;
        switch (pn >> 2) {
            case 0: epi_store<0>(acc, P + (size_t)(pn >> 1) * REG, 512, row0, (pn & 1) * 256 + cw, nullptr, 0); break;
            case 1: epi_store<2, 256, 64>(acc, P + 2 * REG, 64, row0, cw, nullptr, pn - 4); break;
            case 2: epi_store<7>(acc, P + 4 * REG, 1024, row0, (pn - 8) * 256 + cw, nullptr, 0); break;
            default: epi_store<6>(acc, P + 6 * REG, 1024, row0, (pn - 12) * 256 + cw, nullptr, 0); break;
        }
    }
};
template <bool ZB16> struct EpiOut {
    static constexpr bool PERM = true;
    const u16* res; float* Z;
    DI void operator()(const f32x4 (&acc)[2][2][4][2], const pg8::Unit& u, int wr, int wc, int fr, int fq) const {
        const int row0 = u.pm * 256 + wr * 64 + fr, col0 = u.pn * 256 + wc * 32 + 8 * fq;
#pragma unroll
        for (int ai = 0; ai < 2; ++ai) {
            u32x4 r8[4][2];
#pragma unroll
            for (int m = 0; m < 4; ++m)
#pragma unroll
                for (int bj = 0; bj < 2; ++bj) r8[m][bj] = *(const u32x4*)(res + (size_t)(row0 + ai * 128 + m * 16) * 1024 + col0 + bj * 128);
#pragma unroll
            for (int m = 0; m < 4; ++m)
#pragma unroll
                for (int bj = 0; bj < 2; ++bj) {
                    const u32x4 rr = r8[m][bj];
                    f32x4 z0 = {bflo(rr[0]), bfhi(rr[0]), bflo(rr[1]), bfhi(rr[1])}, z1 = {bflo(rr[2]), bfhi(rr[2]), bflo(rr[3]), bfhi(rr[3])};
                    const size_t zo = (size_t)(row0 + ai * 128 + m * 16) * 1024 + col0 + bj * 128;
                    z0 = z0 * ALPHA_RES + acc[ai][bj][m][0]; z1 = z1 * ALPHA_RES + acc[ai][bj][m][1];
                    if (ZB16) { u32x4 w = {pk2(z0[0], z0[1]), pk2(z0[2], z0[3]), pk2(z1[0], z1[1]), pk2(z1[2], z1[3])}; *(u32x4*)(const_cast<u16*>(res) + zo) = w; }
                    else { *(f32x4*)(Z + zo) = z0; *(f32x4*)(Z + zo + 4) = z1; }
                }
        }
    }
};

DI void transpose_w(const float* src, int ld, int cut, int shift, u16* dst, int N, int tile, float* tl) {
    const int nN = N / 64; const int kt = tile / nN, nt = tile % nN; const int k0 = kt * 64, n0 = nt * 64;
    const int tid = ltid();
    const int nsft = n0 >= cut ? shift : 0;
    f32x4 ld4[2];
#pragma unroll
    for (int i = 0; i < 2; ++i) { const int id = tid + 512 * i; const int kk = id >> 4, c4 = id & 15; ld4[i] = __builtin_nontemporal_load((const f32x4*)(src + (size_t)(k0 + kk) * ld + n0 + nsft + 4 * c4)); }
#pragma unroll
    for (int i = 0; i < 2; ++i) { const int id = tid + 512 * i; const int kk = id >> 4, c4 = id & 15; *(f32x4*)(tl + kk * 68 + ((4 * c4 + 4 * (kk >> 3)) & 63)) = ld4[i]; }
    __syncthreads();
    const int nn = tid >> 3, kc = tid & 7;
    float v[8];
#pragma unroll
    for (int e = 0; e < 8; ++e) v[e] = tl[(8 * kc + e) * 68 + ((nn + 4 * kc) & 63)];
    u32x4 w = {pk2(v[0], v[1]), pk2(v[2], v[3]), pk2(v[4], v[5]), pk2(v[6], v[7])};
    *(u32x4*)(dst + (size_t)(n0 + nn) * 1024 + k0 + 8 * kc) = w;
    __syncthreads();
}

DI void phase_prep(const Params& p, unsigned char* lds) {
    float* tl = (float*)lds;
    const int tid = ltid(), wid = tid >> 6, lane = tid & 63;
    for (int t = blockIdx.x; t < 2560; t += gridDim.x) {
        if (t < 1024) transpose_w(p.ab_w_in, 4100, 3584, 4, p.W0T, 4096, t, tl);
        else if (t < 2048) transpose_w(p.c_w_in, 4104, 2048, 8, p.W1T, 4096, t - 1024, tl);
        else if (t < 2304) transpose_w(p.ab_w_out, 1024, 1 << 30, 0, p.W0oT, 1024, t - 2048, tl);
        else transpose_w(p.c_w_out, 1024, 1 << 30, 0, p.W1oT, 1024, t - 2304, tl);
    }
    if (blockIdx.x == 0) {
        if (tid < 512) {
            const float a0 = p.lb_logits[tid], a1 = p.lb_logits[512 + tid], a2 = p.lb_logits[1024 + tid];
            const float mx = fmaxf(a0, fmaxf(a1, a2));
            const float e0 = expf(a0 - mx), e1 = expf(a1 - mx), e2 = expf(a2 - mx);
            p.LB[tid] = e0 / (e0 + e1 + e2);
        }
        if (tid < 128) p.QKM[tid] = 0u;
    }
    float* gw = (float*)lds;
    __syncthreads();
    for (int i = tid; i < 1024; i += 512) *(f32x4*)(gw + ((i & 3) * 256 + (i >> 2)) * 4) = *(const f32x4*)(p.ab_w_in + (size_t)i * 4100 + 3584);
    __syncthreads();
    const float b0 = p.ab_fox_bf[0], b1 = p.ab_fox_bf[1], b2 = p.ab_fox_bf[2], b3 = p.ab_fox_bf[3];
    for (int row0 = (blockIdx.x * 8 + wid) * 4; row0 < T; row0 += gridDim.x * 32) {
        f32x4 xv[4][4];
#pragma unroll
        for (int rr = 0; rr < 4; ++rr)
#pragma unroll
            for (int i = 0; i < 4; ++i) xv[rr][i] = __builtin_nontemporal_load((const f32x4*)(p.x + (size_t)(row0 + rr) * 1024 + 256 * i + 4 * lane));
        float d[16];
#pragma unroll
        for (int e = 0; e < 16; ++e) d[e] = 0.f;
#pragma unroll
        for (int i = 0; i < 4; ++i) {
            const int c = 256 * i + 4 * lane;
#pragma unroll
            for (int e = 0; e < 4; ++e) {
                const f32x4 g = *(const f32x4*)(gw + (e * 256 + 64 * i + lane) * 4);
#pragma unroll
                for (int rr = 0; rr < 4; ++rr) { const float xe = xv[rr][i][e]; d[4 * rr + 0] += xe * g[0]; d[4 * rr + 1] += xe * g[1]; d[4 * rr + 2] += xe * g[2]; d[4 * rr + 3] += xe * g[3]; }
            }
        }
#pragma unroll
        for (int rr = 0; rr < 4; ++rr)
#pragma unroll
            for (int i = 0; i < 4; ++i) { u32x2 w = {pk2(xv[rr][i][0], xv[rr][i][1]), pk2(xv[rr][i][2], xv[rr][i][3])}; *(u32x2*)(p.X16 + (size_t)(row0 + rr) * 1024 + 256 * i + 4 * lane) = w; }
        {
            const float tot = wave_reduce16(d, lane);
            const int j = lane >> 2;
            const int g = j & 3;
            const float bb = g == 0 ? b0 : (g == 1 ? b1 : (g == 2 ? b2 : b3));
            if ((lane & 3) == 0) p.LF[(size_t)(row0 + (j >> 2)) * 4 + g] = log_sigmoid(tot + bb);
        }
    }
}

template <bool GATES>
DI void phase_ln(const Params& p, int layer, unsigned char* lds) {
    const int tid = ltid(), wid = tid >> 6, lane = tid & 63;
    float* gw = (float*)lds;
    if (GATES) {
        __syncthreads();
        for (int i = tid; i < 2048; i += 512) { const int k = i >> 1, hf = i & 1; const int idx = (k & 3) * 256 + (k >> 2); *(f32x4*)(gw + hf * 4096 + idx * 4) = *(const f32x4*)(p.c_w_in + (size_t)k * 4104 + 2048 + hf * 4); }
        __syncthreads();
    }
    const float* lg = p.ln_g + layer * 1024; const float* lbv = p.ln_b + layer * 1024;
    f32x4 g4[4], b4[4];
#pragma unroll
    for (int i = 0; i < 4; ++i) { g4[i] = *(const f32x4*)(lg + 256 * i + 4 * lane); b4[i] = *(const f32x4*)(lbv + 256 * i + 4 * lane); }
    constexpr int R = GATES ? 2 : 8;
    for (int row0 = (blockIdx.x * 8 + wid) * R; row0 < T; row0 += gridDim.x * 8 * R) {
        f32x4 v[R][4]; float s[R];
#pragma unroll
        for (int rr = 0; rr < R; ++rr) {
            s[rr] = 0.f;
#pragma unroll
            for (int i = 0; i < 4; ++i) {
                if (GATES) { const u32x2 zb = *(const u32x2*)(p.X16 + (size_t)(row0 + rr) * 1024 + 256 * i + 4 * lane); v[rr][i] = (f32x4){bflo(zb[0]), bfhi(zb[0]), bflo(zb[1]), bfhi(zb[1])}; }
                else v[rr][i] = *(const f32x4*)(p.out + (size_t)(row0 + rr) * 1024 + 256 * i + 4 * lane);
            }
        }
#pragma unroll
        for (int rr = 0; rr < R; ++rr)
#pragma unroll
            for (int i = 0; i < 4; ++i) s[rr] += v[rr][i][0] + v[rr][i][1] + v[rr][i][2] + v[rr][i][3];
        wave_sum_n<R>(s);
        float q[R];
#pragma unroll
        for (int rr = 0; rr < R; ++rr) {
            s[rr] *= (1.f / 1024.f); q[rr] = 0.f;
#pragma unroll
            for (int i = 0; i < 4; ++i)
#pragma unroll
                for (int e = 0; e < 4; ++e) { const float dd = v[rr][i][e] - s[rr]; q[rr] += dd * dd; }
        }
        wave_sum_n<R>(q);
#pragma unroll
        for (int rr = 0; rr < R; ++rr) {
            const float rstd = rsqrtf(q[rr] * (1.f / 1024.f) + 1e-5f);
#pragma unroll
            for (int i = 0; i < 4; ++i)
#pragma unroll
                for (int e = 0; e < 4; ++e) v[rr][i][e] = (v[rr][i][e] - s[rr]) * rstd * g4[i][e] + b4[i][e];
        }
#pragma unroll
        for (int rr = 0; rr < R; ++rr)
#pragma unroll
            for (int i = 0; i < 4; ++i) {
                const int c = 256 * i + 4 * lane;
                if (!GATES) __builtin_nontemporal_store(v[rr][i], (f32x4*)(p.out + (size_t)(row0 + rr) * 1024 + c));
                if (GATES) { u32x2 w = {pk2(v[rr][i][0], v[rr][i][1]), pk2(v[rr][i][2], v[rr][i][3])}; *(u32x2*)(p.X16 + (size_t)(row0 + rr) * 1024 + c) = w; }
            }
        if (GATES) {
            float d[16];
#pragma unroll
            for (int e = 0; e < 16; ++e) d[e] = 0.f;
#pragma unroll
            for (int i = 0; i < 4; ++i)
#pragma unroll
                for (int e = 0; e < 4; ++e) {
                    const int idx = e * 256 + 64 * i + lane;
                    const f32x4 ga = *(const f32x4*)(gw + idx * 4), gb = *(const f32x4*)(gw + 4096 + idx * 4);
#pragma unroll
                    for (int r2 = 0; r2 < 2; ++r2) {
                        const float y = v[r2 < R ? r2 : 0][i][e];
                        d[8 * r2 + 0] += y * ga[0]; d[8 * r2 + 1] += y * ga[1]; d[8 * r2 + 2] += y * ga[2]; d[8 * r2 + 3] += y * ga[3];
                        d[8 * r2 + 4] += y * gb[0]; d[8 * r2 + 5] += y * gb[1]; d[8 * r2 + 6] += y * gb[2]; d[8 * r2 + 7] += y * gb[3];
                    }
                }
            {
                const float tot = wave_reduce16(d, lane);
                const int j = lane >> 2, r2 = j >> 3, g = j & 7, gi = g & 3;
                if ((lane & 3) == 0) {
                    const size_t row = (size_t)(row0 + r2);
                    const float bias = g < 4 ? p.c_bi[gi] : p.c_bf[gi];
                    if (g < 4) p.IG[row * 4 + gi] = tot + bias; else p.FG[row * 4 + gi] = log_sigmoid(tot + bias);
                }
            }
        }
    }
}

DI void phase_foxprep(const Params& p, unsigned char* lds) {
    const int tid = ltid(), wid = tid >> 6, lane = tid & 63;
    const u16* FQ = p.P + 4 * REG; const u16* FK = p.P + 5 * REG;
    if (blockIdx.x < 16) {
        float* wt = (float*)lds;
        const int bh = blockIdx.x, b = bh >> 2, head = bh & 3;
        float loc[16]; float run = 0.f;
#pragma unroll
        for (int i = 0; i < 16; ++i) { run += p.LF[((size_t)b * SEQ + 16 * tid + i) * 4 + head]; loc[i] = run; }
        float inc = run;
#pragma unroll
        for (int o = 1; o < 64; o <<= 1) { const float t = __shfl_up(inc, o); if (lane >= o) inc += t; }
        __syncthreads();
        if (lane == 63) wt[wid] = inc;
        __syncthreads();
        float off = 0.f;
        for (int w = 0; w < wid; ++w) off += wt[w];
        const float ex = inc - run + off;
#pragma unroll
        for (int i = 0; i < 16; ++i) p.CS[(size_t)bh * SEQ + 16 * tid + i] = ex + loc[i];
        __syncthreads();
    }
}

template <bool OUT>
DI void hgrn_item(const Params& p, int item, unsigned char* lds) {
    const int tid = ltid(), lane = tid & 63, r = lane & 31, h = lane >> 5;
    const int grp = tid >> 8, gt = tid & 255, gw = (tid >> 6) & 3;
    const int b = item >> 6, hp = (item >> 5) & 1, j = item & 31;
    const int head = hp * 2 + grp, bh = b * 4 + head;
    unsigned char* L = lds + grp * 63488;
    u16* Graw = (u16*)(L + 46080); u16* Qraw = (u16*)(L + 54784);
    float* gnl = (float*)(lds + 126976 + grp * 512);
    u16* Qd = (u16*)L; u16* Ki = (u16*)(L + 8704); u16* KeT = (u16*)(L + 17408);
    float* Dk = (float*)(L + 27648); float* hs = (float*)(L + 28160); float* Ost = (float*)(L + 29184);
    const u16* HQ = p.P; const u16* HG = p.P + REG; const u16* HVT = p.P + 2 * REG; const u16* HZ = p.P + 3 * REG;
    f32x16 St[4];
    if (OUT && j > 0) {
        const float* src = p.HS + ((size_t)(bh * 32 + j - 1) << 14);
#pragma unroll
        for (int kt = 0; kt < 4; ++kt)
#pragma unroll
            for (int q4 = 0; q4 < 4; ++q4) { const f32x4 t4 = *(const f32x4*)(src + ((gw * 4 + kt) * 4 + q4) * 256 + lane * 4);
#pragma unroll
                for (int i = 0; i < 4; ++i) St[kt][4 * q4 + i] = t4[i]; }
    } else {
#pragma unroll
        for (int kt = 0; kt < 4; ++kt) St[kt] = zero16();
    }
    float logD0 = 0.f, logD1 = 0.f;
    const int kp = gt & 63, tg = gt >> 6;
    float* hs4 = (float*)(lds + 128000 + grp * 2048);
    if (OUT && gt < 128) gnl[gt] = p.ab_norm_g[head * 128 + gt];
    u32x4 gpre[2], qpre[2]; bf16x8 vpre[2]; s16x4 vppre[2][2];
    {
        const size_t rb0 = (size_t)b * SEQ + j * 256;
        const u16* vr0 = HVT + (((size_t)bh * 256 + ((j * 256) >> 5)) * 128 + 32 * gw + r) * 32;
#pragma unroll
        for (int i = 0; i < 2; ++i) {
            const int id = gt + 256 * i; const size_t go = (rb0 + (id >> 4)) * 512 + head * 128 + (id & 15) * 8;
            gpre[i] = *(const u32x4*)(HG + go); if (OUT) qpre[i] = *(const u32x4*)(HQ + go);
            vpre[i] = *(const bf16x8*)(vr0 + 16 * i + 8 * h);
            if (OUT) { vppre[i][0] = *(const s16x4*)(vr0 + 16 * i + 4 * h); vppre[i][1] = *(const s16x4*)(vr0 + 16 * i + 8 + 4 * h); }
        }
    }
    for (int c = 0; c < 8; ++c) {
        const int s0 = j * 256 + c * 32; const size_t rowbase = (size_t)b * SEQ + s0;
        const u16* vrow = HVT + (((size_t)bh * 256 + (s0 >> 5)) * 128 + 32 * gw + r) * 32;
        bf16x8 vn[2]; s16x4 vp[2][2];
#pragma unroll
        for (int i = 0; i < 2; ++i) {
            const int id = gt + 256 * i;
            *(u32x4*)(Graw + (id >> 4) * 136 + (id & 15) * 8) = gpre[i];
            if (OUT) *(u32x4*)(Qraw + (id >> 4) * 136 + (id & 15) * 8) = qpre[i];
            vn[i] = vpre[i];
            if (OUT) { vp[i][0] = vppre[i][0]; vp[i][1] = vppre[i][1]; }
        }
        if (c < 7) {
            const u16* vr1 = vrow + 128 * 32;
#pragma unroll
            for (int i = 0; i < 2; ++i) {
                const int id = gt + 256 * i; const size_t go = (rowbase + 32 + (id >> 4)) * 512 + head * 128 + (id & 15) * 8;
                gpre[i] = *(const u32x4*)(HG + go); if (OUT) qpre[i] = *(const u32x4*)(HQ + go);
                vpre[i] = *(const bf16x8*)(vr1 + 16 * i + 8 * h);
                if (OUT) { vppre[i][0] = *(const s16x4*)(vr1 + 16 * i + 4 * h); vppre[i][1] = *(const s16x4*)(vr1 + 16 * i + 8 + 4 * h); }
            }
        }
        __syncthreads();
        float g0[8], g1[8], q0[8], q1[8], c0[8], c1[8];
#pragma unroll
        for (int i = 0; i < 8; ++i) {
            const unsigned gw2 = *(const unsigned*)(Graw + (8 * tg + i) * 136 + 2 * kp);
            g0[i] = h2f((u16)(gw2 & 0xffffu)); g1[i] = h2f((u16)(gw2 >> 16));
            if (OUT) { const unsigned qw2 = *(const unsigned*)(Qraw + (8 * tg + i) * 136 + 2 * kp); q0[i] = bflo(qw2); q1[i] = bfhi(qw2); }
        }
        float run0 = 0.f, run1 = 0.f;
#pragma unroll
        for (int i = 0; i < 8; ++i) { run0 += g0[i]; c0[i] = run0; run1 += g1[i]; c1[i] = run1; }
        *(f32x2*)(hs4 + tg * 128 + 2 * kp) = (f32x2){run0, run1};
        __syncthreads();
        float off0 = 0.f, off1 = 0.f, bl0 = 0.f, bl1 = 0.f;
#pragma unroll
        for (int t4 = 0; t4 < 4; ++t4) { const f32x2 hv = *(const f32x2*)(hs4 + t4 * 128 + 2 * kp); bl0 += hv[0]; bl1 += hv[1]; if (t4 < tg) { off0 += hv[0]; off1 += hv[1]; } }
        const float D0 = __expf(bl0), D1 = __expf(bl1);
        float ke0[8], ke1[8];
#pragma unroll
        for (int i = 0; i < 8; ++i) {
            const float bb0 = c0[i] + off0, bb1 = c1[i] + off1;
            const float kk0 = 1.f - __expf(g0[i]), kk1 = 1.f - __expf(g1[i]);
            const float ki0 = kk0 * __expf(-bb0), ki1 = kk1 * __expf(-bb1);
            ke0[i] = ki0 * D0; ke1[i] = ki1 * D1;
            if (OUT) {
                *(unsigned*)(Qd + (8 * tg + i) * 136 + 2 * kp) = pk2(q0[i] * __expf(bb0), q1[i] * __expf(bb1));
                *(unsigned*)(Ki + (8 * tg + i) * 136 + 2 * kp) = pk2(ki0, ki1);
            }
        }
        { u32x4 w0 = {pk2(ke0[0], ke0[1]), pk2(ke0[2], ke0[3]), pk2(ke0[4], ke0[5]), pk2(ke0[6], ke0[7])}, w1 = {pk2(ke1[0], ke1[1]), pk2(ke1[2], ke1[3]), pk2(ke1[4], ke1[5]), pk2(ke1[6], ke1[7])};
          *(u32x4*)(KeT + (2 * kp) * 40 + 8 * tg) = w0; *(u32x4*)(KeT + (2 * kp + 1) * 40 + 8 * tg) = w1; }
        if (tg == 0) { *(f32x2*)(Dk + 2 * kp) = (f32x2){D0, D1}; logD0 += bl0; logD1 += bl1; }
        __syncthreads();
        f32x16 o;
        if (OUT) {
            f32x16 aT = zero16();
#pragma unroll
            for (int ks = 0; ks < 8; ++ks) { const bf16x8 A = *(const bf16x8*)(Ki + r * 136 + 16 * ks + 8 * h), B = *(const bf16x8*)(Qd + r * 136 + 16 * ks + 8 * h); aT = MFMA32(A, B, aT); }
#pragma unroll
            for (int rg = 0; rg < 16; ++rg) if (crow(rg, h) > r) aT[rg] = 0.f;
            const bf16x8 PA0 = pack8<0>(aT), PA1 = pack8<8>(aT);
            o = zero16();
            o = MFMA32(PA0, join4(vp[0][0], vp[0][1]), o);
            o = MFMA32(PA1, join4(vp[1][0], vp[1][1]), o);
#pragma unroll
            for (int kt = 0; kt < 4; ++kt) {
                { const bf16x8 Bs = pack8<0>(St[kt]);
                  const s16x4 lo = *(const s16x4*)(Qd + r * 136 + 32 * kt + 4 * h), hi = *(const s16x4*)(Qd + r * 136 + 32 * kt + 8 + 4 * h);
                  o = MFMA32(join4(lo, hi), Bs, o); }
                { const bf16x8 Bs = pack8<8>(St[kt]);
                  const s16x4 lo = *(const s16x4*)(Qd + r * 136 + 32 * kt + 16 + 4 * h), hi = *(const s16x4*)(Qd + r * 136 + 32 * kt + 24 + 4 * h);
                  o = MFMA32(join4(lo, hi), Bs, o); }
            }
        }
#pragma unroll
        for (int kt = 0; kt < 4; ++kt) {
#pragma unroll
            for (int gg = 0; gg < 4; ++gg) { const f32x4 dk = *(const f32x4*)(Dk + 32 * kt + 8 * gg + 4 * h);
#pragma unroll
                for (int i = 0; i < 4; ++i) St[kt][4 * gg + i] *= dk[i]; }
#pragma unroll
            for (int sp = 0; sp < 2; ++sp) { const bf16x8 A = *(const bf16x8*)(KeT + (32 * kt + r) * 40 + 16 * sp + 8 * h); St[kt] = MFMA32(A, vn[sp], St[kt]); }
        }
        if (OUT) {
#pragma unroll
            for (int rg = 0; rg < 16; ++rg) Ost[crow(rg, h) * 132 + 32 * gw + r] = o[rg];
            __syncthreads();
            const int t = gt >> 3, seg = gt & 7;
            f32x4 xv[4]; float ss = 0.f;
#pragma unroll
            for (int i = 0; i < 4; ++i) { xv[i] = *(const f32x4*)(Ost + t * 132 + 16 * seg + 4 * i); ss += xv[i][0] * xv[i][0] + xv[i][1] * xv[i][1] + xv[i][2] * xv[i][2] + xv[i][3] * xv[i][3]; }
            ss = xsum<1>(ss); ss = xsum<2>(ss); ss = xsum<4>(ss);
            const float rs = rsqrtf(ss * (1.f / 128.f) + 1e-6f);
            const size_t row = rowbase + t; const int col = head * 128 + 16 * seg;
            const u32x4 z0 = *(const u32x4*)(HZ + row * 512 + col), z1 = *(const u32x4*)(HZ + row * 512 + col + 8);
            float ov[16];
#pragma unroll
            for (int i = 0; i < 4; ++i) { const f32x4 gn = *(const f32x4*)(gnl + 16 * seg + 4 * i);
#pragma unroll
                for (int e = 0; e < 4; ++e) ov[4 * i + e] = xv[i][e] * rs * gn[e]; }
#pragma unroll
            for (int e = 0; e < 4; ++e) { ov[2 * e] *= bflo(z0[e]); ov[2 * e + 1] *= bfhi(z0[e]); ov[8 + 2 * e] *= bflo(z1[e]); ov[8 + 2 * e + 1] *= bfhi(z1[e]); }
            u32x4 w0 = {pk2(ov[0], ov[1]), pk2(ov[2], ov[3]), pk2(ov[4], ov[5]), pk2(ov[6], ov[7])}, w1 = {pk2(ov[8], ov[9]), pk2(ov[10], ov[11]), pk2(ov[12], ov[13]), pk2(ov[14], ov[15])};
            *(u32x4*)(p.M + row * 1024 + col) = w0; *(u32x4*)(p.M + row * 1024 + col + 8) = w1;
        }
    }
    if (!OUT) {
        float* dst = p.HS + ((size_t)(bh * 32 + j) << 14);
#pragma unroll
        for (int kt = 0; kt < 4; ++kt)
#pragma unroll
            for (int q4 = 0; q4 < 4; ++q4) { f32x4 t4 = {St[kt][4 * q4], St[kt][4 * q4 + 1], St[kt][4 * q4 + 2], St[kt][4 * q4 + 3]};
                *(f32x4*)(dst + ((gw * 4 + kt) * 4 + q4) * 256 + lane * 4) = t4; }
        if (tg == 0) *(f32x2*)(p.HD + (size_t)(bh * 32 + j) * 128 + 2 * kp) = (f32x2){__expf(logD0), __expf(logD1)};
    }
    __syncthreads();
}

DI void hgrn_scan(const Params& p) {
    for (int e = blockIdx.x * 512 + ltid(); e < 16 * 4096; e += gridDim.x * 512) {
        const int bh = e >> 12, qd = e & 4095;
        const int ln = qd & 63, q4 = (qd >> 6) & 3, kt = (qd >> 8) & 3;
        const int k0 = 32 * kt + 8 * q4 + 4 * (ln >> 5);
        f32x4 s = {0.f, 0.f, 0.f, 0.f};
#pragma unroll
        for (int hb = 0; hb < 2; ++hb) {
            const int j0 = hb * 16, nj = hb ? 15 : 16;
            f32x4 u[16], d[16];
#pragma unroll
            for (int jj = 0; jj < 16; ++jj) if (jj < nj) { u[jj] = *(const f32x4*)(p.HS + ((size_t)(bh * 32 + j0 + jj) << 14) + qd * 4); d[jj] = *(const f32x4*)(p.HD + (size_t)(bh * 32 + j0 + jj) * 128 + k0); }
#pragma unroll
            for (int jj = 0; jj < 16; ++jj) if (jj < nj) { s = d[jj] * s + u[jj]; u[jj] = s; }
#pragma unroll
            for (int jj = 0; jj < 16; ++jj) if (jj < nj) *(f32x4*)(p.HS + ((size_t)(bh * 32 + j0 + jj) << 14) + qd * 4) = u[jj];
        }
    }
}

DI void fox_item(const Params& p, int item, unsigned char* lds) {
    const int tid = ltid(), wid = __builtin_amdgcn_readfirstlane(tid >> 6), lane = tid & 63, r = lane & 31, h = lane >> 5;
    const int bid8 = item & 255, rnd = item >> 8;
    const int bh = 2 * (bid8 & 7) + rnd, qb = 31 - (bid8 >> 3), b = bh >> 2, head = bh & 3;
    const int t0 = qb * 256;
    const u16* FQ = p.P + 4 * REG; const u16* FK = p.P + 5 * REG; const u16* FVT = p.P + 6 * REG; const u16* FZ = p.P + 7 * REG;
    const float* CSb = p.CS + (size_t)bh * SEQ;
    int* misc = (int*)(lds + 72192);
    const int jd = qb * 4 + 3;
    const int tq = t0 + 32 * wid + r;
    const size_t row_t = (size_t)b * SEQ + tq;
    bf16x8 qf[8];
#pragma unroll
    for (int ks = 0; ks < 8; ++ks) qf[ks] = *(const bf16x8*)(FQ + row_t * 512 + head * 128 + 16 * ks + 8 * h);
    const float ct = CSb[tq];
    float m = -1e30f, l = 0.f;
    f32x16 O[4];
#pragma unroll
    for (int mt = 0; mt < 4; ++mt) O[mt] = zero16();
    u32x4 kreg[2], vreg[2]; float creg = 0.f;
    const int kr0 = tid >> 4, kc = tid & 15, vr0 = tid >> 3, vc = tid & 7;
    auto gload = [&](int jt) {
#pragma unroll
        for (int i = 0; i < 2; ++i) {
            kreg[i] = *(const u32x4*)(FK + ((size_t)b * SEQ + 64 * jt + kr0 + 32 * i) * 512 + head * 128 + kc * 8);
            vreg[i] = *(const u32x4*)(FVT + (((size_t)bh * 128 + jt) * 128 + vr0 + 64 * i) * 64 + vc * 8);
        }
        if (tid < 64) creg = CSb[64 * jt + tid];
    };
    auto lwrite = [&](int buf) {
        u16* Kt = (u16*)(lds + buf * 17408); u16* Vt = (u16*)(lds + 34816 + buf * 18432); float* cs = (float*)(lds + 71680 + buf * 256);
#pragma unroll
        for (int i = 0; i < 2; ++i) {
            *(u32x4*)(Kt + (kr0 + 32 * i) * 136 + kc * 8) = kreg[i];
            *(u32x4*)(Vt + (vr0 + 64 * i) * 72 + vc * 8) = vreg[i];
        }
        if (tid < 64) cs[tid] = creg;
    };
    gload(jd);
    const float bq = __uint_as_float(p.QKM[bh * 4]) + __uint_as_float(p.QKM[bh * 4 + 1]) + __uint_as_float(p.QKM[bh * 4 + 2]) + __uint_as_float(p.QKM[bh * 4 + 3]);
    const float bk = __uint_as_float(p.QKM[64 + bh * 4]) + __uint_as_float(p.QKM[64 + bh * 4 + 1]) + __uint_as_float(p.QKM[64 + bh * 4 + 2]) + __uint_as_float(p.QKM[64 + bh * 4 + 3]);
    const float bound = 2.f * sqrtf(bq * bk) * 1.01f + 106.f;
    const float ct0 = CSb[t0];
    float cprobe = 0.f;
    if (tid < 128 && tid < qb * 4) cprobe = CSb[64 * tid + 63];
    __syncthreads();
    if (tid == 0) misc[0] = 0;
    __syncthreads();
    if (tid < 128 && tid < qb * 4) { if (cprobe - ct0 > bound) atomicMax(misc, tid + 1); }
    lwrite(0);
    __syncthreads();
    const int j_lo = misc[0];
    int buf = 0;
    for (int jt = jd; jt >= j_lo; --jt) {
        if (jt > j_lo) gload(jt - 1);
        if (64 * jt <= t0 + 32 * wid + 31) {
            const u16* Kt = (const u16*)(lds + buf * 17408); const u16* Vt = (const u16*)(lds + 34816 + buf * 18432); const float* cs = (const float*)(lds + 71680 + buf * 256);
            f32x16 sT[2];
            __builtin_amdgcn_s_setprio(1);
            const bool live1 = (64 * jt + 32 <= t0 + 32 * wid + 31);
#pragma unroll
            for (int kt = 0; kt < 2; ++kt) {
                sT[kt] = zero16();
                if (kt == 0 || live1) {
#pragma unroll
                    for (int ks = 0; ks < 8; ++ks) { const bf16x8 A = *(const bf16x8*)(Kt + (32 * kt + r) * 136 + 16 * ks + 8 * h); sT[kt] = MFMA32(A, qf[ks], sT[kt]); }
                }
            }
            __builtin_amdgcn_s_setprio(0);
            const bool needmask = (64 * jt + 63 > t0 + 32 * wid);
            float mx = -__builtin_inff();
#pragma unroll
            for (int kt = 0; kt < 2; ++kt)
#pragma unroll
                for (int gg = 0; gg < 4; ++gg) {
                    const f32x4 cc = *(const f32x4*)(cs + 32 * kt + 8 * gg + 4 * h);
#pragma unroll
                    for (int i = 0; i < 4; ++i) {
                        float v = sT[kt][4 * gg + i] + (ct - cc[i]);
                        if (needmask) { const int key = 64 * jt + 32 * kt + 8 * gg + 4 * h + i; if (key > tq) v = -__builtin_inff(); }
                        sT[kt][4 * gg + i] = v; mx = fmaxf(mx, v);
                    }
                }
            mx = xmax<32>(mx);
            const float mn = fmaxf(m, mx);
            const float alpha = __expf(m - mn); m = mn;
            float ps = 0.f;
#pragma unroll
            for (int kt = 0; kt < 2; ++kt)
#pragma unroll
                for (int rg = 0; rg < 16; ++rg) { const float pv = __expf(sT[kt][rg] - mn); sT[kt][rg] = pv; ps += pv; }
            ps = xsum<32>(ps);
            l = l * alpha + ps;
            if (__any(alpha != 1.f)) {
#pragma unroll
                for (int mt = 0; mt < 4; ++mt)
#pragma unroll
                    for (int rg = 0; rg < 16; ++rg) O[mt][rg] *= alpha;
            }
            const bf16x8 PB00 = pack8<0>(sT[0]), PB01 = pack8<8>(sT[0]), PB10 = pack8<0>(sT[1]), PB11 = pack8<8>(sT[1]);
            __builtin_amdgcn_s_setprio(1);
#pragma unroll
            for (int mt = 0; mt < 4; ++mt) {
                const u16* vb = Vt + (32 * mt + r) * 72 + 4 * h;
                O[mt] = MFMA32(join4(*(const s16x4*)(vb), *(const s16x4*)(vb + 8)), PB00, O[mt]);
                O[mt] = MFMA32(join4(*(const s16x4*)(vb + 16), *(const s16x4*)(vb + 24)), PB01, O[mt]);
                if (live1) {
                    O[mt] = MFMA32(join4(*(const s16x4*)(vb + 32), *(const s16x4*)(vb + 40)), PB10, O[mt]);
                    O[mt] = MFMA32(join4(*(const s16x4*)(vb + 48), *(const s16x4*)(vb + 56)), PB11, O[mt]);
                }
            }
            __builtin_amdgcn_s_setprio(0);
        }
        if (jt > j_lo) lwrite(buf ^ 1);
        __syncthreads();
        buf ^= 1;
    }
    const float inv = 1.f / l;
    u32x4 zz[4][2];
#pragma unroll
    for (int mt = 0; mt < 4; ++mt)
#pragma unroll
        for (int a2 = 0; a2 < 2; ++a2) zz[mt][a2] = *(const u32x4*)(FZ + row_t * 512 + head * 128 + 32 * mt + 16 * a2 + 8 * h);
#pragma unroll
    for (int mt = 0; mt < 4; ++mt)
#pragma unroll
        for (int a2 = 0; a2 < 2; ++a2) {
            float lo4[4], hi4[4];
#pragma unroll
            for (int i = 0; i < 4; ++i) {
                auto rr = __builtin_amdgcn_permlane32_swap(__float_as_uint(O[mt][8 * a2 + i]), __float_as_uint(O[mt][8 * a2 + 4 + i]), false, false);
                lo4[i] = __uint_as_float(rr[0]); hi4[i] = __uint_as_float(rr[1]);
            }
            const u32x4 z = zz[mt][a2];
            u32x4 w;
            w.x = pk2(lo4[0] * inv * bflo(z[0]), lo4[1] * inv * bfhi(z[0]));
            w.y = pk2(lo4[2] * inv * bflo(z[1]), lo4[3] * inv * bfhi(z[1]));
            w.z = pk2(hi4[0] * inv * bflo(z[2]), hi4[1] * inv * bfhi(z[2]));
            w.w = pk2(hi4[2] * inv * bflo(z[3]), hi4[3] * inv * bfhi(z[3]));
            *(u32x4*)(p.M + row_t * 1024 + 512 + head * 128 + 32 * mt + 16 * a2 + 8 * h) = w;
        }
}

template <bool OUT>
DI void mlstm_item(const Params& p, int item, unsigned char* lds) {
    const int tid = ltid(), wid = __builtin_amdgcn_readfirstlane(tid >> 6), lane = tid & 63, r = lane & 31, h = lane >> 5;
    const int bh = item >> 4, j = item & 15, b = bh >> 2, head = bh & 3;
    u16* Qs = (u16*)lds; u16* Ks = (u16*)(lds + 17408); u16* KwT = (u16*)(lds + 34816);
    float* uS = (float*)(lds + 53248); float* rowA = uS + 64; float* sint = uS + 128; float* nfl = uS + 192; float* wk = uS + 256;
    float* misc = (float*)(lds + 54528);
    float* nf = (float*)(lds + 54592); u16* n16 = (u16*)(lds + 55104); float* npart = (float*)(lds + 55360);
    float* Ost = (float*)(lds + 57408);
    u16* VTs = (u16*)(lds + 123968);
    float* gnl = (float*)(lds + 160832);
    const u16* MQ = p.P; const u16* MK = p.P + REG; const u16* MVT = p.P + 2 * REG; const u16* MO = p.P + 4 * REG; const u16* MZ = p.P + 6 * REG;
    const int slotp = bh * 16 + j - 1;
    f32x16 Ct[4];
    if (OUT && j > 0) {
        const float* src = p.MS + (size_t)slotp * 32768;
#pragma unroll
        for (int kt = 0; kt < 4; ++kt)
#pragma unroll
            for (int q4 = 0; q4 < 4; ++q4) { const f32x4 t4 = *(const f32x4*)(src + ((wid * 4 + kt) * 4 + q4) * 256 + lane * 4);
#pragma unroll
                for (int i = 0; i < 4; ++i) Ct[kt][4 * q4 + i] = t4[i]; }
    } else {
#pragma unroll
        for (int kt = 0; kt < 4; ++kt) Ct[kt] = zero16();
    }
    __syncthreads();
    if (tid < 128) { const float nv = (OUT && j > 0) ? p.MN[(size_t)slotp * 128 + tid] : 0.f; nf[tid] = nv; n16[tid] = f2bf(nv); }
    if (OUT && tid >= 256) gnl[tid - 256] = p.c_norm_g[head * 256 + (tid - 256)];
    float m_prev = OUT ? (j > 0 ? p.MM[slotp] : 0.f) : -1e30f;
    float Bsum = 0.f;
    float my_bc, my_u, my_cm, my_blast, my_cml;
    {
        const size_t grow = (size_t)b * SEQ + j * 512 + wid * 64 + lane;
        const float lf = p.FG[grow * 4 + head], ig = p.IG[grow * 4 + head];
        float bc = lf;
#pragma unroll
        for (int o = 1; o < 64; o <<= 1) { const float t = __shfl_up(bc, o); if (lane >= o) bc += t; }
        const float u = ig - bc;
        float cm = u;
#pragma unroll
        for (int o = 1; o < 64; o <<= 1) { const float t = __shfl_up(cm, o); if (lane >= o) cm = fmaxf(cm, t); }
        my_bc = bc; my_u = u; my_cm = cm;
        my_blast = __shfl(bc, 63); my_cml = __shfl(cm, 63);
        if (lane == 0) misc[4 + wid] = my_blast;
    }
    u32x4 vpre[4], kpre[3], qpre[3];
    {
        const int s00 = j * 512;
#pragma unroll
        for (int i = 0; i < 4; ++i) { const int id = tid + 512 * i; if (!OUT) vpre[i] = *(const u32x4*)(MVT + (((size_t)bh * 128 + (s00 >> 6)) * 256 + (id >> 3)) * 64 + (id & 7) * 8); }
#pragma unroll
        for (int i = 0; i < 3; ++i) { const int id = tid + 512 * i; const int rr = id < 1072 ? (id >> 4) : 0, c16 = id & 15; const int sidx = s00 - 3 + rr;
            const size_t go = ((size_t)b * SEQ + (sidx < 0 ? 0 : sidx)) * 512 + head * 128 + c16 * 8;
            kpre[i] = *(const u32x4*)(MK + go); if (OUT) qpre[i] = *(const u32x4*)(MQ + go); }
    }
#pragma unroll 1
    for (int c = 0; c < 8; ++c) {
        int tl = tid; asm volatile("" : "+v"(tl));
        const int lane = tl & 63, r = lane & 31, h = lane >> 5;
        const int k = tl & 127, tqd = tl >> 7;
        const int colq = head * 128 + k;
        float cwq[4], cwk[4];
#pragma unroll
        for (int e = 0; e < 4; ++e) { cwq[e] = p.c_conv_w[e * 1024 + colq]; cwk[e] = p.c_conv_w[e * 1024 + 512 + colq]; }
        const float cbq = p.c_conv_b[colq], cbk = p.c_conv_b[512 + colq];
        const int s0 = j * 512 + c * 64; const size_t rowbase = (size_t)b * SEQ + s0;
        u32x4 vst[4];
        const u16* vrow = VTs + (32 * wid + r) * 72;
        u16* Kraw = (u16*)Ost; u16* Qraw = (u16*)((unsigned char*)Ost + 18432);
        if (OUT) {
#pragma unroll
            for (int i = 0; i < 4; ++i) { const int id = tl + 512 * i; vst[i] = *(const u32x4*)(MVT + (((size_t)bh * 128 + (s0 >> 6)) * 256 + (id >> 3)) * 64 + (id & 7) * 8); }
        } else {
#pragma unroll
            for (int i = 0; i < 4; ++i) vst[i] = vpre[i];
        }
#pragma unroll
        for (int i = 0; i < 3; ++i) {
            const int id = tl + 512 * i;
            if (id < 1072) {
                const int rr = id >> 4, c16 = id & 15;
                u32x4 kv4 = kpre[i]; u32x4 qv4; if (OUT) qv4 = qpre[i];
                if (s0 - 3 + rr < 0) { kv4 = (u32x4){0u, 0u, 0u, 0u}; if (OUT) qv4 = (u32x4){0u, 0u, 0u, 0u}; }
                *(u32x4*)(Kraw + rr * 136 + c16 * 8) = kv4;
                if (OUT) *(u32x4*)(Qraw + rr * 136 + c16 * 8) = qv4;
            }
        }
        if (!OUT && c < 7) {
            const int s1 = s0 + 64;
#pragma unroll
            for (int i = 0; i < 4; ++i) { const int id = tl + 512 * i; vpre[i] = *(const u32x4*)(MVT + (((size_t)bh * 128 + (s1 >> 6)) * 256 + (id >> 3)) * 64 + (id & 7) * 8); }
#pragma unroll
            for (int i = 0; i < 3; ++i) { const int id = tl + 512 * i; const int rr = id < 1072 ? (id >> 4) : 0, c16 = id & 15;
                kpre[i] = *(const u32x4*)(MK + ((size_t)b * SEQ + (s1 - 3 + rr)) * 512 + head * 128 + c16 * 8); }
        }
        __syncthreads();
        if (wid == c) {
            const float bc = my_bc, u = my_u, cm = my_cm, blast = my_blast, cml = my_cml;
            const float Mx = fmaxf(m_prev, cm);
            uS[lane] = u; rowA[lane] = -Mx; sint[lane] = __expf(m_prev - Mx); nfl[lane] = __expf(-(bc + Mx));
            const float mnew = blast + fmaxf(m_prev, cml);
            wk[lane] = __expf(blast + u - mnew);
            if (lane == 0) { misc[0] = __expf(blast + m_prev - mnew); misc[1] = mnew; }
        }
        float kv[16], qv[16];
        {
            float rawk[19], rawq[19];
#pragma unroll
            for (int i = 0; i < 19; ++i) {
                rawk[i] = bf2f(Kraw[(16 * tqd + i) * 136 + k]);
                if (OUT) rawq[i] = bf2f(Qraw[(16 * tqd + i) * 136 + k]);
            }
#pragma unroll
            for (int i = 0; i < 16; ++i) {
                const float ak = cbk + cwk[0] * rawk[i] + cwk[1] * rawk[i + 1] + cwk[2] * rawk[i + 2] + cwk[3] * rawk[i + 3];
                kv[i] = silu_fast(ak) * QSCALE;
                if (OUT) { const float aq = cbq + cwq[0] * rawq[i] + cwq[1] * rawq[i + 1] + cwq[2] * rawq[i + 2] + cwq[3] * rawq[i + 3]; qv[i] = silu_fast(aq); }
            }
        }
        __syncthreads();
        const float decay = misc[0], mnew_r = misc[1];
        {
            float kw[16]; float np = 0.f;
#pragma unroll
            for (int i = 0; i < 16; ++i) {
                const int t = 16 * tqd + i;
                if (OUT) { Qs[t * 136 + k] = f2bf(qv[i]); Ks[t * 136 + k] = f2bf(kv[i]); }
                kw[i] = kv[i] * wk[t]; np += kw[i];
            }
            u32x4 w0 = {pk2(kw[0], kw[1]), pk2(kw[2], kw[3]), pk2(kw[4], kw[5]), pk2(kw[6], kw[7])}, w1 = {pk2(kw[8], kw[9]), pk2(kw[10], kw[11]), pk2(kw[12], kw[13]), pk2(kw[14], kw[15])};
            *(u32x4*)(KwT + k * 72 + 16 * tqd) = w0; *(u32x4*)(KwT + k * 72 + 16 * tqd + 8) = w1;
            npart[tqd * 128 + k] = np;
#pragma unroll
            for (int i = 0; i < 4; ++i) { const int id = tl + 512 * i; *(u32x4*)(VTs + (id >> 3) * 72 + (id & 7) * 8) = vst[i]; }
        }
        __syncthreads();
        if (OUT) {
            u32x4 onesw = {0x3F803F80u, 0x3F803F80u, 0x3F803F80u, 0x3F803F80u};
            const bf16x8 ONES = __builtin_bit_cast(bf16x8, onesw);
#pragma unroll 1
            for (int tt = 0; tt < 2; ++tt) {
                f32x16 oi = zero16(), di = zero16();
                const float rA = rowA[32 * tt + r];
#pragma unroll
                for (int kt = 0; kt < 4; ++kt) {
                    { const bf16x8 Bc = pack8<0>(Ct[kt]);
                      const bf16x8 Bn = join4(*(const s16x4*)(n16 + 32 * kt + 4 * h), *(const s16x4*)(n16 + 32 * kt + 8 + 4 * h));
                      const bf16x8 A = join4(*(const s16x4*)(Qs + (32 * tt + r) * 136 + 32 * kt + 4 * h), *(const s16x4*)(Qs + (32 * tt + r) * 136 + 32 * kt + 8 + 4 * h));
                      oi = MFMA32(A, Bc, oi); di = MFMA32(A, Bn, di); }
                    { const bf16x8 Bc = pack8<8>(Ct[kt]);
                      const bf16x8 Bn = join4(*(const s16x4*)(n16 + 32 * kt + 16 + 4 * h), *(const s16x4*)(n16 + 32 * kt + 24 + 4 * h));
                      const bf16x8 A = join4(*(const s16x4*)(Qs + (32 * tt + r) * 136 + 32 * kt + 16 + 4 * h), *(const s16x4*)(Qs + (32 * tt + r) * 136 + 32 * kt + 24 + 4 * h));
                      oi = MFMA32(A, Bc, oi); di = MFMA32(A, Bn, di); }
                }
#pragma unroll
                for (int gg = 0; gg < 4; ++gg) {
                    const f32x4 si = *(const f32x4*)(sint + 32 * tt + 8 * gg + 4 * h);
#pragma unroll
                    for (int i = 0; i < 4; ++i) { oi[4 * gg + i] *= si[i]; di[4 * gg + i] *= si[i]; }
                }
#pragma unroll
                for (int st = 0; st < 2; ++st) if (st <= tt) {
                    const s16x4 vp00 = *(const s16x4*)(vrow + 32 * st + 4 * h), vp01 = *(const s16x4*)(vrow + 32 * st + 8 + 4 * h);
                    const s16x4 vp10 = *(const s16x4*)(vrow + 32 * st + 16 + 4 * h), vp11 = *(const s16x4*)(vrow + 32 * st + 24 + 4 * h);
                    f32x16 a = zero16();
#pragma unroll
                    for (int ks = 0; ks < 8; ++ks) { const bf16x8 A = *(const bf16x8*)(Ks + (32 * st + r) * 136 + 16 * ks + 8 * h), B = *(const bf16x8*)(Qs + (32 * tt + r) * 136 + 16 * ks + 8 * h); a = MFMA32(A, B, a); }
#pragma unroll
                    for (int gg = 0; gg < 4; ++gg) { const f32x4 uu = *(const f32x4*)(uS + 32 * st + 8 * gg + 4 * h);
#pragma unroll
                        for (int i = 0; i < 4; ++i) { float w = __expf(rA + uu[i]); if (st == tt && (8 * gg + 4 * h + i) > r) w = 0.f; a[4 * gg + i] *= w; } }
                    const bf16x8 PA0 = pack8<0>(a), PA1 = pack8<8>(a);
                    oi = MFMA32(PA0, join4(vp00, vp01), oi); oi = MFMA32(PA1, join4(vp10, vp11), oi);
                    di = MFMA32(PA0, ONES, di); di = MFMA32(PA1, ONES, di);
                }
#pragma unroll
                for (int gg = 0; gg < 4; ++gg) {
                    const f32x4 nf4 = *(const f32x4*)(nfl + 32 * tt + 8 * gg + 4 * h);
#pragma unroll
                    for (int i = 0; i < 4; ++i)
                        Ost[(32 * tt + 8 * gg + 4 * h + i) * 260 + 32 * wid + r] = oi[4 * gg + i] * frcp(fmaxf(fabsf(di[4 * gg + i]), nf4[i]));
                }
            }
        }
        bf16x8 vn[4];
#pragma unroll
        for (int q4 = 0; q4 < 4; ++q4) vn[q4] = *(const bf16x8*)(vrow + 16 * q4 + 8 * h);
#pragma unroll
        for (int kt = 0; kt < 4; ++kt) {
#pragma unroll
            for (int rg = 0; rg < 16; ++rg) Ct[kt][rg] *= decay;
#pragma unroll
            for (int q4 = 0; q4 < 4; ++q4) { const bf16x8 A = *(const bf16x8*)(KwT + (32 * kt + r) * 72 + 16 * q4 + 8 * h); Ct[kt] = MFMA32(A, vn[q4], Ct[kt]); }
        }
        if (OUT) {
            __syncthreads();
            if (c < 7) {
                const int s1 = s0 + 64;
#pragma unroll
                for (int i = 0; i < 3; ++i) { const int id = tl + 512 * i; const int rr = id < 1072 ? (id >> 4) : 0, c16 = id & 15;
                    const size_t go = ((size_t)b * SEQ + (s1 - 3 + rr)) * 512 + head * 128 + c16 * 8;
                    kpre[i] = *(const u32x4*)(MK + go); qpre[i] = *(const u32x4*)(MQ + go); }
            }
            const int t = tl >> 3, seg = tl & 7;
            const size_t row = rowbase + t; const int col = head * 256 + 32 * seg;
            u32x4 mo[4], mz[4]; f32x4 gng[4][2];
#pragma unroll
            for (int i = 0; i < 4; ++i) { mo[i] = *(const u32x4*)(MO + row * 1024 + col + 8 * i); mz[i] = *(const u32x4*)(MZ + row * 1024 + col + 8 * i);
                gng[i][0] = *(const f32x4*)(gnl + 32 * seg + 8 * i); gng[i][1] = *(const f32x4*)(gnl + 32 * seg + 8 * i + 4); }
            float ss = 0.f;
#pragma unroll
            for (int i = 0; i < 4; ++i) {
                const f32x4 x0 = *(const f32x4*)(Ost + t * 260 + 32 * seg + 8 * i), x1 = *(const f32x4*)(Ost + t * 260 + 32 * seg + 8 * i + 4);
                const float y0 = x0[0] * bflo(mo[i][0]), y1 = x0[1] * bfhi(mo[i][0]), y2 = x0[2] * bflo(mo[i][1]), y3 = x0[3] * bfhi(mo[i][1]);
                const float y4 = x1[0] * bflo(mo[i][2]), y5 = x1[1] * bfhi(mo[i][2]), y6 = x1[2] * bflo(mo[i][3]), y7 = x1[3] * bfhi(mo[i][3]);
                ss += y0 * y0 + y1 * y1 + y2 * y2 + y3 * y3 + y4 * y4 + y5 * y5 + y6 * y6 + y7 * y7;
            }
            ss = xsum<1>(ss); ss = xsum<2>(ss); ss = xsum<4>(ss);
            const float rs = rsqrtf(ss * (1.f / 256.f) + 1e-6f);
#pragma unroll
            for (int i = 0; i < 4; ++i) {
                const f32x4 x0 = *(const f32x4*)(Ost + t * 260 + 32 * seg + 8 * i), x1 = *(const f32x4*)(Ost + t * 260 + 32 * seg + 8 * i + 4);
                const f32x4 g0 = gng[i][0], g1 = gng[i][1];
                u32x4 w;
                w.x = pk2(x0[0] * bflo(mo[i][0]) * rs * g0[0] * bflo(mz[i][0]), x0[1] * bfhi(mo[i][0]) * rs * g0[1] * bfhi(mz[i][0]));
                w.y = pk2(x0[2] * bflo(mo[i][1]) * rs * g0[2] * bflo(mz[i][1]), x0[3] * bfhi(mo[i][1]) * rs * g0[3] * bfhi(mz[i][1]));
                w.z = pk2(x1[0] * bflo(mo[i][2]) * rs * g1[0] * bflo(mz[i][2]), x1[1] * bfhi(mo[i][2]) * rs * g1[1] * bfhi(mz[i][2]));
                w.w = pk2(x1[2] * bflo(mo[i][3]) * rs * g1[2] * bflo(mz[i][3]), x1[3] * bfhi(mo[i][3]) * rs * g1[3] * bfhi(mz[i][3]));
                *(u32x4*)(p.M + row * 1024 + col + 8 * i) = w;
            }
        }
        if (tid < 128) { const float nv = decay * nf[tid] + npart[tid] + npart[128 + tid] + npart[256 + tid] + npart[384 + tid]; nf[tid] = nv; n16[tid] = f2bf(nv); }
        m_prev = mnew_r;
        if (OUT) __syncthreads();
    }
    if (!OUT) {
        const int slot = bh * 16 + j;
        float* dst = p.MS + (size_t)slot * 32768;
#pragma unroll
        for (int kt = 0; kt < 4; ++kt)
#pragma unroll
            for (int q4 = 0; q4 < 4; ++q4) { f32x4 t4 = {Ct[kt][4 * q4], Ct[kt][4 * q4 + 1], Ct[kt][4 * q4 + 2], Ct[kt][4 * q4 + 3]};
                *(f32x4*)(dst + ((wid * 4 + kt) * 4 + q4) * 256 + lane * 4) = t4; }
        __syncthreads();
        if (tid < 128) p.MN[(size_t)slot * 128 + tid] = nf[tid];
        if (tid == 0) { float bs = 0.f; for (int w8 = 0; w8 < 8; ++w8) bs += misc[4 + w8]; p.MSC[slot * 2] = m_prev; p.MSC[slot * 2 + 1] = bs; }
    }
    __syncthreads();
}

DI void mlstm_scan(const Params& p) {
    constexpr int PERQ = 8192 + 32;
    for (int e = blockIdx.x * 512 + ltid(); e < 16 * PERQ; e += gridDim.x * 512) {
        const int bh = e / PERQ, idx = e % PERQ;
        f32x4 u[15]; float ca[15], cb[15];
        float m = 0.f;
#pragma unroll
        for (int j = 0; j < 15; ++j) {
            const int slot = bh * 16 + j;
            u[j] = idx < 8192 ? *(const f32x4*)(p.MS + (size_t)slot * 32768 + idx * 4) : *(const f32x4*)(p.MN + (size_t)slot * 128 + (idx - 8192) * 4);
            const float mu = p.MSC[slot * 2], Bs = p.MSC[slot * 2 + 1];
            const float mn = fmaxf(Bs + m, mu);
            ca[j] = __expf(Bs + m - mn); cb[j] = __expf(mu - mn); m = mn;
            if (idx == 0) p.MM[slot] = mn;
        }
        f32x4 s = {0.f, 0.f, 0.f, 0.f};
#pragma unroll
        for (int j = 0; j < 15; ++j) { s = s * ca[j] + u[j] * cb[j]; u[j] = s; }
#pragma unroll
        for (int j = 0; j < 15; ++j) {
            const int slot = bh * 16 + j;
            if (idx < 8192) *(f32x4*)(p.MS + (size_t)slot * 32768 + idx * 4) = u[j]; else *(f32x4*)(p.MN + (size_t)slot * 128 + (idx - 8192) * 4) = u[j];
        }
    }
}

#define XB_TMO      128
#define XB_XCNT(j)  (256  + 64 * (j))
#define XB_XSUB(j)  (1280 + 64 * (j))
#define XB_XGEN(j)  (2304 + 64 * (j))
#define XB_TOP      3328
#define XB_TOPGEN   3392
#define XCD_BAR_WORDS 3456
#define XB_SPIN_CAP (1u << 18)
DI unsigned xb_ld(unsigned* p)              { return __hip_atomic_load(p, __ATOMIC_RELAXED, __HIP_MEMORY_SCOPE_AGENT); }
DI unsigned xb_add(unsigned* p, unsigned v) { return __hip_atomic_fetch_add(p, v, __ATOMIC_RELAXED, __HIP_MEMORY_SCOPE_AGENT); }
DI unsigned xb_xcc_id() { return (unsigned)__builtin_amdgcn_s_getreg((3 << 11) | 20) & 0xFu; }
#define XB_SPIN(cond, bar) do { unsigned _sp = 0; while (cond) { __builtin_amdgcn_s_sleep(1); \
    if ((++_sp & 255u) == 0u) { if (xb_ld(&(bar)[XB_TMO])) break; if (_sp > XB_SPIN_CAP) { atomicAdd(&(bar)[XB_TMO], 1u); break; } } } } while (0)
struct XcdBarrier { unsigned* bar; unsigned x; volatile LAS unsigned* st; };
DI XcdBarrier xcd_barrier_post(unsigned* bar, volatile LAS unsigned* st) {
    XcdBarrier b; b.bar = bar; b.x = xb_xcc_id(); b.st = st;
    if (threadIdx.x == 0) (void)xb_add(&bar[XB_XCNT(b.x)], 1u);
    return b;
}
DI void xcd_barrier_complete(unsigned* bar, unsigned x, unsigned& nloc, unsigned& nx) {
    const unsigned G = gridDim.x * gridDim.y * gridDim.z;
    unsigned sum, cnt, mine, sp = 0u;
    for (;;) {
        sum = 0u; cnt = 0u; mine = 0u;
#pragma unroll
        for (unsigned j = 0; j < 16; ++j) { const unsigned c = xb_ld(&bar[XB_XCNT(j)]); sum += c; cnt += (c > 0u) ? 1u : 0u; mine = (j == x) ? c : mine; }
        if (sum == G) break;
        __builtin_amdgcn_s_sleep(1);
        if ((++sp & 255u) == 0u) { if (xb_ld(&bar[XB_TMO])) break; if (sp > XB_SPIN_CAP) { atomicAdd(&bar[XB_TMO], 1u); break; } }
    }
    nloc = mine > 0u ? mine : 1u; nx = cnt > 0u ? cnt : 1u;
}
DI void xcd_barrier(const XcdBarrier& b) {
    asm volatile("s_waitcnt vmcnt(0)" ::: "memory");
    __syncthreads();
    if (threadIdx.x == 0) {
        unsigned* bar = b.bar;
        __builtin_amdgcn_s_waitcnt(0);
        unsigned nloc = b.st[0], nx = b.st[1];
        if (nloc == 0u) { xcd_barrier_complete(bar, b.x, nloc, nx); b.st[0] = nloc; b.st[1] = nx; }
        const unsigned old = xb_add(&bar[XB_XSUB(b.x)], 1u);
        const unsigned gen = old / nloc;
        if (old + 1u == (gen + 1u) * nloc) {
            __builtin_amdgcn_fence(__ATOMIC_RELEASE, "agent");
            asm volatile("s_waitcnt vmcnt(0)" ::: "memory");
            const unsigned og = xb_add(&bar[XB_TOP], 1u);
            const unsigned tg = og / nx;
            if (og + 1u == (tg + 1u) * nx) xb_add(&bar[XB_TOPGEN], 1u);
            else XB_SPIN(xb_ld(&bar[XB_TOPGEN]) == tg, bar);
            __builtin_amdgcn_fence(__ATOMIC_ACQUIRE, "agent");
            xb_add(&bar[XB_XGEN(b.x)], 1u);
            asm volatile("s_waitcnt vmcnt(0)" ::: "memory");
        } else {
            XB_SPIN(xb_ld(&bar[XB_XGEN(b.x)]) == gen, bar);
            __builtin_amdgcn_fence(__ATOMIC_ACQUIRE, "agent");
            asm volatile("s_waitcnt vmcnt(0)" ::: "memory");
        }
    }
    __syncthreads();
}

#ifndef REP_A
#define REP_A 1
#endif
#ifndef REP_B
#define REP_B 1
#endif
#ifndef REP_C
#define REP_C 1
#endif
#ifndef REP_FOX
#define REP_FOX 1
#endif
#ifndef REP_HGC
#define REP_HGC 1
#endif
#ifndef REP_MLC
#define REP_MLC 1
#endif
#ifndef REP_S
#define REP_S 1
#endif
#define GSYNC() do { for (int _s = 0; _s < REP_S; ++_s) xcd_barrier(xb); } while (0)
__global__ void __launch_bounds__(512, 2) mega(Params p) {
    extern __shared__ __attribute__((aligned(16))) unsigned char shm[];
    cg::grid_group grid = cg::this_grid();
    const int G = gridDim.x, bid = blockIdx.x;
    volatile LAS unsigned* xst = (volatile LAS unsigned*)((LAS unsigned char*)shm + (LDS_BYTES - 16));
    if (threadIdx.x == 0) { xst[0] = 0u; xst[1] = 0u; }
    __syncthreads();
    const XcdBarrier xb = xcd_barrier_post(p.bar, xst);
    if (p.never) grid.sync();
    for (int rep = 0; rep < REP_C; ++rep) { phase_prep(p, shm); GSYNC(); }
    for (int rep = 0; rep < REP_C; ++rep) { pg8::StaticOrder S; S.init(T, 4096, G, bid); pg8::Gemm g{p.X16, p.W0T, T, 4096, 1024}; EpiIn0 E{p.P, p.LB, p.QKM}; pg8::gemm_phase(( LAS unsigned char*)shm, g, S, E); GSYNC(); }
    for (int rep = 0; rep < REP_A; ++rep) { for (int it = bid; it < 256; it += G) hgrn_item<false>(p, it, shm);
    phase_foxprep(p, shm);
    GSYNC(); }
    hgrn_scan(p);
    for (int rep = 0; rep < REP_FOX; ++rep) { for (int it = bid; it < 512; it += G) fox_item(p, it, shm);
    GSYNC(); }
    for (int rep = 0; rep < REP_HGC; ++rep) { for (int it = bid; it < 256; it += G) hgrn_item<true>(p, it, shm);
    GSYNC(); }
    { pg8::StaticOrder S; S.init(T, 1024, G, bid); pg8::Gemm g{p.M, p.W0oT, T, 1024, 1024}; EpiOut<true> E{p.X16, p.out}; pg8::gemm_phase((LAS unsigned char*)shm, g, S, E); }
    GSYNC();
    phase_ln<true>(p, 0, shm);
    GSYNC();
    { pg8::StaticOrder S; S.init(T, 4096, G, bid); pg8::Gemm g{p.X16, p.W1T, T, 4096, 1024}; EpiIn1 E{p.P}; pg8::gemm_phase((LAS unsigned char*)shm, g, S, E); }
    GSYNC();
    for (int rep = 0; rep < REP_B; ++rep) { for (int it = bid; it < 256; it += G) mlstm_item<false>(p, it, shm);
    GSYNC(); }
    mlstm_scan(p);
    GSYNC();
    for (int rep = 0; rep < REP_MLC; ++rep) { for (int it = bid; it < 256; it += G) mlstm_item<true>(p, it, shm);
    GSYNC(); }
    { pg8::StaticOrder S; S.init(T, 1024, G, bid); pg8::Gemm g{p.M, p.W1oT, T, 1024, 1024}; EpiOut<false> E{p.X16, p.out}; pg8::gemm_phase((LAS unsigned char*)shm, g, S, E); }
    GSYNC();
    phase_ln<false>(p, 1, shm);
}

extern "C" void kernel_launch(void* const* d_in, const int* in_sizes, int n_in, void* d_out, int out_size, void* d_ws, size_t ws_size, hipStream_t stream) {
    static int grid_blocks = 0;
    if (!grid_blocks) {
        int dev = 0, cus = 0, per_cu = 0;
        hipGetDevice(&dev);
        hipDeviceGetAttribute(&cus, hipDeviceAttributeMultiprocessorCount, dev);
        hipFuncSetAttribute((const void*)mega, hipFuncAttributeMaxDynamicSharedMemorySize, LDS_BYTES);
        hipOccupancyMaxActiveBlocksPerMultiprocessor(&per_cu, mega, 512, LDS_BYTES);
        if (per_cu < 1) per_cu = 1;
        if (per_cu > 1) per_cu = 1;
        grid_blocks = cus * per_cu;
    }
    Params p{};
    p.x = (const float*)d_in[0]; p.lb_logits = (const float*)d_in[1]; p.ab_w_in = (const float*)d_in[2]; p.ab_fox_bf = (const float*)d_in[3];
    p.ab_norm_g = (const float*)d_in[4]; p.ab_w_out = (const float*)d_in[5]; p.c_w_in = (const float*)d_in[6]; p.c_conv_w = (const float*)d_in[7];
    p.c_conv_b = (const float*)d_in[8]; p.c_bi = (const float*)d_in[9]; p.c_bf = (const float*)d_in[10]; p.c_norm_g = (const float*)d_in[11];
    p.c_w_out = (const float*)d_in[12]; p.ln_g = (const float*)d_in[13]; p.ln_b = (const float*)d_in[14];
    p.out = (float*)d_out;
    unsigned char* w = (unsigned char*)d_ws;
    const size_t MiB = 1048576;
    p.W0T = (u16*)(w); p.W1T = (u16*)(w + 8 * MiB); p.W0oT = (u16*)(w + 16 * MiB); p.W1oT = (u16*)(w + 18 * MiB);
    p.X16 = (u16*)(w + 20 * MiB);
    p.P = (u16*)(w + 84 * MiB);
    p.M = (u16*)(w + 340 * MiB);
    unsigned char* sm = w + 404 * MiB;
    p.LF = (float*)(sm); p.CS = (float*)(sm + 1 * MiB); p.IG = (float*)(sm + 2 * MiB); p.FG = (float*)(sm + 3 * MiB);
    p.LB = (float*)(sm + 4 * MiB); p.QKM = (unsigned*)(sm + 4 * MiB + 4096);
    p.MSC = (float*)(sm + 4 * MiB + 8192); p.MM = (float*)(sm + 4 * MiB + 16384);
    p.bar = (unsigned*)(sm + 5 * MiB); p.never = 0; p.pad_ = 0;
    p.HS = (float*)(w + 416 * MiB); p.HD = (float*)(w + 416 * MiB + 32 * MiB);
    p.MS = (float*)(w + 416 * MiB); p.MN = (float*)(w + 416 * MiB + 32 * MiB);
    if (ws_size < 450 * MiB) { fprintf(stderr, "workspace too small: %zu\n", ws_size); return; }
    (void)hipMemsetAsync(p.bar, 0, XCD_BAR_WORDS * sizeof(unsigned), stream);
    void* args[] = {&p};
    hipError_t e = hipLaunchCooperativeKernel((const void*)mega, dim3(grid_blocks), dim3(512), args, LDS_BYTES, stream);
    if (e != hipSuccess) fprintf(stderr, "cooperative launch failed: %s (grid %d)\n", hipGetErrorString(e), grid_blocks);
}
```

```cpp
#include <hip/hip_runtime.h>
#include <hip/hip_cooperative_groups.h>
#include <cstdio>
namespace cg = cooperative_groups;

#define DI __device__ __forceinline__
#define LAS __attribute__((address_space(3)))
typedef unsigned short u16;
typedef short bf16x8 __attribute__((ext_vector_type(8)));
typedef short s16x4 __attribute__((ext_vector_type(4)));
typedef float f32x2 __attribute__((ext_vector_type(2)));
typedef float f32x4 __attribute__((ext_vector_type(4)));
typedef float f32x16 __attribute__((ext_vector_type(16)));
typedef unsigned u32x2 __attribute__((ext_vector_type(2)));
typedef unsigned u32x4 __attribute__((ext_vector_type(4)));

constexpr int T = 32768, SEQ = 8192;
constexpr float ALPHA_RES = 1.4142135623730951f;
constexpr float QSCALE = 0.08838834764831845f;
constexpr size_t REG = (size_t)T * 512;
constexpr int LDS_BYTES = 163840;

struct Params {
    const float* x; const float* lb_logits; const float* ab_w_in; const float* ab_fox_bf; const float* ab_norm_g; const float* ab_w_out;
    const float* c_w_in; const float* c_conv_w; const float* c_conv_b; const float* c_bi; const float* c_bf; const float* c_norm_g; const float* c_w_out;
    const float* ln_g; const float* ln_b;
    float* out;
    u16* W0T; u16* W1T; u16* W0oT; u16* W1oT; u16* X16; u16* P; u16* M;
    float* LF; float* CS; float* IG; float* FG; float* LB; unsigned* QKM;
    float* HS; float* HD; float* MS; float* MN; float* MSC; float* MM;
    unsigned* bar; int never; int pad_;
};

DI unsigned pk2(float a, float b) {
    typedef __bf16 bf2 __attribute__((ext_vector_type(2)));
    f32x2 v = {a, b};
    bf2 r = __builtin_convertvector(v, bf2);
    return __builtin_bit_cast(unsigned, r);
}
DI u16 f2bf(float a) { return (u16)(pk2(a, 0.f) & 0xffffu); }
DI float bf2f(u16 b) { return __uint_as_float(((unsigned)b) << 16); }
DI float bflo(unsigned w) { return __uint_as_float(w << 16); }
DI float bfhi(unsigned w) { return __uint_as_float(w & 0xffff0000u); }
DI u16 f2h(float a) { _Float16 hh = (_Float16)a; return __builtin_bit_cast(u16, hh); }
DI float h2f(u16 b) { return (float)__builtin_bit_cast(_Float16, b); }
DI int crow(int reg, int h) { return (reg & 3) + 8 * (reg >> 2) + 4 * h; }
DI f32x16 zero16() { f32x16 z; _Pragma("unroll") for (int i = 0; i < 16; ++i) z[i] = 0.f; return z; }
template <int O> DI bf16x8 pack8(const f32x16& x) {
    u32x4 w = {pk2(x[O], x[O + 1]), pk2(x[O + 2], x[O + 3]), pk2(x[O + 4], x[O + 5]), pk2(x[O + 6], x[O + 7])};
    return __builtin_bit_cast(bf16x8, w);
}
DI bf16x8 join4(s16x4 lo, s16x4 hi) { return __builtin_shufflevector(lo, hi, 0, 1, 2, 3, 4, 5, 6, 7); }
#define MFMA32(a, b, c) __builtin_amdgcn_mfma_f32_32x32x16_bf16((a), (b), (c), 0, 0, 0)
DI float log_sigmoid(float x) { return fminf(x, 0.f) - log1pf(expf(-fabsf(x))); }
DI float frcp(float x) { return __builtin_amdgcn_rcpf(x); }
DI float sigmoidf_(float x) { return 1.f / (1.f + __expf(-x)); }
DI float siluf_(float x) { return x / (1.f + __expf(-x)); }
DI float silu_fast(float x) { return x * frcp(1.f + __expf(-x)); }
DI int lane_id_raw() { return (int)__builtin_amdgcn_mbcnt_hi(~0u, __builtin_amdgcn_mbcnt_lo(~0u, 0u)); }
template <int M> DI float xlane(float v) {
    if constexpr (M == 32) {
        const unsigned u = __float_as_uint(v);
        auto rr = __builtin_amdgcn_permlane32_swap(u, u, false, false);
        const bool hi = lane_id_raw() >= 32;
        return __uint_as_float(hi ? rr[0] : rr[1]);
    } else {
        return __int_as_float(__builtin_amdgcn_ds_swizzle(__float_as_int(v), (M << 10) | 0x1f));
    }
}
template <int M> DI float xsum(float v) {
    if constexpr (M == 32) {
        const unsigned u = __float_as_uint(v);
        auto rr = __builtin_amdgcn_permlane32_swap(u, u, false, false);
        return __uint_as_float(rr[0]) + __uint_as_float(rr[1]);
    } else return v + xlane<M>(v);
}
template <int M> DI float xmax(float v) {
    if constexpr (M == 32) {
        const unsigned u = __float_as_uint(v);
        auto rr = __builtin_amdgcn_permlane32_swap(u, u, false, false);
        return fmaxf(__uint_as_float(rr[0]), __uint_as_float(rr[1]));
    } else return fmaxf(v, xlane<M>(v));
}
template <int N> DI void wave_sum_n(float (&v)[N]) {
#pragma unroll
    for (int i = 0; i < N; ++i) v[i] = xsum<32>(v[i]);
#pragma unroll
    for (int i = 0; i < N; ++i) v[i] = xsum<16>(v[i]);
#pragma unroll
    for (int i = 0; i < N; ++i) v[i] = xsum<8>(v[i]);
#pragma unroll
    for (int i = 0; i < N; ++i) v[i] = xsum<4>(v[i]);
#pragma unroll
    for (int i = 0; i < N; ++i) v[i] = xsum<2>(v[i]);
#pragma unroll
    for (int i = 0; i < N; ++i) v[i] = xsum<1>(v[i]);
}
DI int ltid() { int t = threadIdx.x; asm volatile("" : "+v"(t)); return t; }
DI float wave_reduce16(const float (&d)[16], int lane) {
    const bool b5 = lane & 32, b4 = lane & 16, b3 = lane & 8, b2 = lane & 4;
    float a8[8];
#pragma unroll
    for (int i = 0; i < 8; ++i) { const float keep = b5 ? d[8 + i] : d[i], snd = b5 ? d[i] : d[8 + i]; a8[i] = keep + xlane<32>(snd); }
    float a4[4];
#pragma unroll
    for (int i = 0; i < 4; ++i) { const float keep = b4 ? a8[4 + i] : a8[i], snd = b4 ? a8[i] : a8[4 + i]; a4[i] = keep + xlane<16>(snd); }
    float a2[2];
#pragma unroll
    for (int i = 0; i < 2; ++i) { const float keep = b3 ? a4[2 + i] : a4[i], snd = b3 ? a4[i] : a4[2 + i]; a2[i] = keep + xlane<8>(snd); }
    float a1;
    { const float keep = b2 ? a2[1] : a2[0], snd = b2 ? a2[0] : a2[1]; a1 = keep + xlane<4>(snd); }
    a1 = xsum<2>(a1); a1 = xsum<1>(a1);
    return a1;
}
DI float wave_sum(float v) {
    v = xsum<32>(v); v = xsum<16>(v); v = xsum<8>(v); v = xsum<4>(v); v = xsum<2>(v); v = xsum<1>(v);
    return v;
}

namespace pg8 {
constexpr int BM = 256, BK = 64, HALF = 128, HTB = HALF * BK * 2, STAGE_BYTES = 8 * HTB, NXCD = 8, WGM = 8;
DI int lds_byte(int r, int c) { const int st = (r >> 4) * 2 + (c >> 5), rr = r & 15, cc = c & 31, ob = rr * 64 + cc * 2; return st * 1024 + (ob ^ (((ob >> 9) & 1) << 5)); }
DI void stage_rc(int b, int& R, int& C) { const int st = b / 1024, sb = b % 1024, swz = sb ^ (((sb >> 9) & 1) << 5); R = (st >> 1) * 16 + swz / 64; C = (st & 1) * 32 + (swz % 64) / 2; }
DI int perm32(int rho) { const int n = rho >> 4, i = rho & 15; return 8 * (i >> 2) + 4 * n + (i & 3); }
struct Unit { int pm, pn; };
struct Gemm { const u16* A; const u16* Bt; int M, N, K; };
struct StaticOrder {
    int nM, nN, nwg, G, c;
    DI void init(int M, int N, int G_, int c_) { nM = M / BM; nN = N / BM; nwg = nM * nN; G = G_; c = c_; }
    DI bool next(int i, Unit& u) const {
        const long L = (long)i * G + c; if (L >= nwg) return false;
        int wgid = (int)L; { const int q = nwg / NXCD, r = nwg % NXCD, xcd = wgid % NXCD, off = wgid / NXCD; wgid = (xcd < r ? xcd * (q + 1) : r * (q + 1) + (xcd - r) * q) + off; }
        const int nig = WGM * nN, gid = wgid / nig, fm = gid * WGM, gsz = (nM - fm) < WGM ? (nM - fm) : WGM;
        u.pm = fm + ((wgid % nig) % gsz); u.pn = (wgid % nig) / gsz; return true;
    }
};

template <class Epi>
DI void gemm_phase(LAS unsigned char* lds, const Gemm g, const StaticOrder& S, const Epi& E) {
    int tid = threadIdx.x; asm volatile("" : "+v"(tid));
    const int wid = __builtin_amdgcn_readfirstlane(tid >> 6), lane = tid & 63, wr = wid >> 2, wc = wid & 3, fr = lane & 15, fq = lane >> 4;
    const int K = g.K, nt = K / BK;
    unsigned voffA[2], voffB[2];
#pragma unroll
    for (int i = 0; i < 2; ++i) { int R, C; stage_rc(tid * 16 + i * 8192, R, C); const int Rb = Epi::PERM ? ((R & ~31) + perm32(R & 31)) : R;
        voffA[i] = (unsigned)(R * K + C) * 2u; voffB[i] = (unsigned)(Rb * K + C) * 2u; }
    const size_t kstep = (size_t)(BK * 2);
    const size_t hstep = (size_t)HALF * K * 2;
    const size_t tstep = 2 * hstep;
    const unsigned ldsw = (unsigned)wid * 1024u;
    const int aoff = lds_byte(wr * 64 + fr, fq * 8), boff = lds_byte(wc * 32 + fr, fq * 8);
#define PG8_SA(b, h) (((b) * 2 + (h)) * HTB)
#define PG8_SB(b, h) ((4 + (b) * 2 + (h)) * HTB)
#define PG8_STAGE(bufoff, gbase, voff) do { _Pragma("unroll") for (int _i = 0; _i < 2; ++_i) \
        __builtin_amdgcn_global_load_lds((const unsigned*)((const char*)(gbase) + (voff)[_i]), (LAS unsigned*)(lds + (bufoff) + ldsw + _i * 8192), 16, 0, 0); } while (0)
#define PG8_LDA(dst, b, h) do { _Pragma("unroll") for (int m = 0; m < 4; ++m) _Pragma("unroll") for (int k = 0; k < 2; ++k) dst[m][k] = *(const LAS bf16x8*)(lds + PG8_SA(b, h) + aoff + m * 2048 + k * 1024); } while (0)
#define PG8_LDB(dst, b, h) do { _Pragma("unroll") for (int n = 0; n < 2; ++n) _Pragma("unroll") for (int k = 0; k < 2; ++k) dst[n][k] = *(const LAS bf16x8*)(lds + PG8_SB(b, h) + boff + n * 2048 + k * 1024); } while (0)
#define PG8_MMA(ai, bj, At, Bt) do { __builtin_amdgcn_s_setprio(1); _Pragma("unroll") for (int m = 0; m < 4; ++m) _Pragma("unroll") for (int n = 0; n < 2; ++n) _Pragma("unroll") for (int k = 0; k < 2; ++k) \
        acc[ai][bj][m][n] = __builtin_amdgcn_mfma_f32_16x16x32_bf16(Bt[n][k], At[m][k], acc[ai][bj][m][n], 0, 0, 0); __builtin_amdgcn_s_setprio(0); } while (0)
#define PG8_WAIT_V(n) asm volatile("s_waitcnt vmcnt(" #n ")" ::: "memory")
#define PG8_WAIT_L(n) asm volatile("s_waitcnt lgkmcnt(" #n ")" ::: "memory")
#define PG8_BAR __builtin_amdgcn_s_barrier()
#define PG8_SCHED __builtin_amdgcn_sched_barrier(0)
    Unit cur, nxt; int ui = 0;
    if (!S.next(0, cur)) return;
    f32x4 acc[2][2][4][2];
#pragma unroll
    for (int a = 0; a < 2; ++a)
#pragma unroll
        for (int b = 0; b < 2; ++b)
#pragma unroll
            for (int m = 0; m < 4; ++m)
#pragma unroll
                for (int n = 0; n < 2; ++n) acc[a][b][m][n] = (f32x4){0.f, 0.f, 0.f, 0.f};
    bf16x8 At[4][2], B0[2][2], B1[2][2];
    const char* cA = (const char*)g.A + (size_t)cur.pm * tstep; const char* cB = (const char*)g.Bt + (size_t)cur.pn * tstep;
    PG8_STAGE(PG8_SB(0, 0), cB, voffB); PG8_STAGE(PG8_SA(0, 0), cA, voffA); PG8_STAGE(PG8_SB(0, 1), cB + hstep, voffB); PG8_STAGE(PG8_SA(0, 1), cA + hstep, voffA);
    if (wr == 1) PG8_BAR;
    PG8_WAIT_V(4); PG8_BAR;
    PG8_STAGE(PG8_SB(1, 0), cB + kstep, voffB); PG8_STAGE(PG8_SA(1, 0), cA + kstep, voffA); PG8_STAGE(PG8_SB(1, 1), cB + hstep + kstep, voffB);
    PG8_WAIT_V(6); PG8_BAR;
    for (;;) {
        const bool has_next = S.next(ui + 1, nxt);
        const char* nA = has_next ? (const char*)g.A + (size_t)nxt.pm * tstep : cA; const char* nB = has_next ? (const char*)g.Bt + (size_t)nxt.pn * tstep : cB;
        for (int t = 0; t < nt; t += 2) {
            const bool last = (t == nt - 2);
            const char* a1 = cA + (size_t)(t + 1) * kstep;
            const char* a2 = last ? nA : cA + (size_t)(t + 2) * kstep; const char* b2 = last ? nB : cB + (size_t)(t + 2) * kstep;
            const char* a3 = a2 + kstep; const char* b3 = b2 + kstep;
            PG8_LDB(B0, 0, 0); PG8_SCHED; PG8_LDA(At, 0, 0); PG8_STAGE(PG8_SA(1, 1), a1 + hstep, voffA);
            PG8_WAIT_L(8); PG8_BAR; PG8_WAIT_L(0); PG8_MMA(0, 0, At, B0); PG8_BAR; PG8_SCHED;
            PG8_LDB(B1, 0, 1); PG8_STAGE(PG8_SB(0, 0), b2, voffB);
            PG8_BAR; PG8_WAIT_L(0); PG8_MMA(0, 1, At, B1); PG8_BAR;
            PG8_LDA(At, 0, 1); PG8_STAGE(PG8_SA(0, 0), a2, voffA);
            PG8_BAR; PG8_WAIT_L(0); PG8_MMA(1, 0, At, B0); PG8_BAR; PG8_SCHED;
            PG8_STAGE(PG8_SB(0, 1), b2 + hstep, voffB);
            PG8_WAIT_V(6); PG8_BAR; PG8_MMA(1, 1, At, B1); PG8_BAR;
            PG8_LDB(B0, 1, 0); PG8_SCHED; PG8_LDA(At, 1, 0); PG8_STAGE(PG8_SA(0, 1), a2 + hstep, voffA);
            PG8_WAIT_L(8); PG8_BAR; PG8_WAIT_L(0); PG8_MMA(0, 0, At, B0); PG8_BAR; PG8_SCHED;
            PG8_LDB(B1, 1, 1); PG8_STAGE(PG8_SB(1, 0), b3, voffB);
            PG8_BAR; PG8_WAIT_L(0); PG8_MMA(0, 1, At, B1); PG8_BAR;
            PG8_LDA(At, 1, 1); PG8_STAGE(PG8_SA(1, 0), a3, voffA);
            PG8_BAR; PG8_WAIT_L(0); PG8_MMA(1, 0, At, B0); PG8_BAR; PG8_SCHED;
            PG8_STAGE(PG8_SB(1, 1), b3 + hstep, voffB);
            PG8_WAIT_V(6); PG8_BAR; PG8_MMA(1, 1, At, B1); PG8_BAR;
        }
        E(acc, cur, wr, wc, fr, fq);
        if (!has_next) break;
#pragma unroll
        for (int a = 0; a < 2; ++a)
#pragma unroll
            for (int b = 0; b < 2; ++b)
#pragma unroll
                for (int m = 0; m < 4; ++m)
#pragma unroll
                    for (int n = 0; n < 2; ++n) acc[a][b][m][n] = (f32x4){0.f, 0.f, 0.f, 0.f};
        cur = nxt; cA = nA; cB = nB; ++ui;
    }
    PG8_WAIT_V(0);
    if (wr == 0) PG8_BAR;
    PG8_BAR;
#undef PG8_SA
#undef PG8_SB
#undef PG8_STAGE
#undef PG8_LDA
#undef PG8_LDB
#undef PG8_MMA
#undef PG8_WAIT_V
#undef PG8_WAIT_L
#undef PG8_BAR
#undef PG8_SCHED
}
}

template <int MODE, int DV = 128, int TLc = 64, int NRM = 0, int NT = 1>
DI void epi_store(const f32x4 (&acc)[2][2][4][2], u16* base, int ld, int row0, int col0, const float* lb, int head0, unsigned* qkm = nullptr) {
    float rmax[2] = {0.f, 0.f};
    f32x4 lbv[2][2];
    if (MODE == 1) {
#pragma unroll
        for (int bj = 0; bj < 2; ++bj) { lbv[bj][0] = *(const f32x4*)(lb + col0 + bj * 128); lbv[bj][1] = *(const f32x4*)(lb + col0 + bj * 128 + 4); }
    }
#pragma unroll
    for (int ai = 0; ai < 2; ++ai)
#pragma unroll
        for (int m = 0; m < 4; ++m) {
            const int row = row0 + ai * 128 + m * 16;
#pragma unroll
            for (int bj = 0; bj < 2; ++bj) {
                const int col = col0 + bj * 128;
                float v[8];
#pragma unroll
                for (int e = 0; e < 4; ++e) { v[e] = acc[ai][bj][m][0][e]; v[4 + e] = acc[ai][bj][m][1][e]; }
                if (MODE == 1) {
                    const f32x4 l0 = lbv[bj][0], l1 = lbv[bj][1];
#pragma unroll
                    for (int e = 0; e < 8; ++e) { const float l = e < 4 ? l0[e & 3] : l1[e & 3]; const float f = l + (1.f - l) * frcp(1.f + __expf(-v[e])); v[e] = __logf(f); }
                    u32x4 w;
                    w.x = (unsigned)f2h(v[0]) | ((unsigned)f2h(v[1]) << 16); w.y = (unsigned)f2h(v[2]) | ((unsigned)f2h(v[3]) << 16);
                    w.z = (unsigned)f2h(v[4]) | ((unsigned)f2h(v[5]) << 16); w.w = (unsigned)f2h(v[6]) | ((unsigned)f2h(v[7]) << 16);
                    *(u32x4*)(base + (size_t)row * ld + col) = w;
                } else if (MODE == 2) {
                    const int frl = row0 & 15;
                    const bool b0 = frl & 1, b1 = frl & 2, b2 = frl & 4;
                    const unsigned w0 = pk2(v[0], v[1]), w1 = pk2(v[2], v[3]), w2 = pk2(v[4], v[5]), w3 = pk2(v[6], v[7]);
                    const unsigned mine0 = b0 ? w2 : w0, mine1 = b0 ? w3 : w1, snd0 = b0 ? w0 : w2, snd1 = b0 ? w1 : w3;
                    const unsigned r0 = __float_as_uint(xlane<1>(__uint_as_float(snd0))), r1 = __float_as_uint(xlane<1>(__uint_as_float(snd1)));
                    unsigned E[4];
#pragma unroll
                    for (int i = 0; i < 4; ++i) {
                        const unsigned a = (i >> 1) ? mine1 : mine0, bq = (i >> 1) ? r1 : r0;
                        const unsigned ha = (i & 1) ? (a >> 16) : (a & 0xffffu), hb = (i & 1) ? (bq >> 16) : (bq & 0xffffu);
                        E[i] = b0 ? (hb | (ha << 16)) : (ha | (hb << 16));
                    }
                    const unsigned kE0 = b1 ? E[2] : E[0], kE1 = b1 ? E[3] : E[1], sE0 = b1 ? E[0] : E[2], sE1 = b1 ? E[1] : E[3];
                    const unsigned rE0 = __float_as_uint(xlane<2>(__uint_as_float(sE0))), rE1 = __float_as_uint(xlane<2>(__uint_as_float(sE1)));
                    const unsigned F0lo = b1 ? rE0 : kE0, F0hi = b1 ? kE0 : rE0, F1lo = b1 ? rE1 : kE1, F1hi = b1 ? kE1 : rE1;
                    const unsigned kFlo = b2 ? F1lo : F0lo, kFhi = b2 ? F1hi : F0hi, sFlo = b2 ? F0lo : F1lo, sFhi = b2 ? F0hi : F1hi;
                    const unsigned rFlo = __float_as_uint(xlane<4>(__uint_as_float(sFlo))), rFhi = __float_as_uint(xlane<4>(__uint_as_float(sFhi)));
                    u32x4 G;
                    G.x = b2 ? rFlo : kFlo; G.y = b2 ? rFhi : kFhi; G.z = b2 ? kFlo : rFlo; G.w = b2 ? kFhi : rFhi;
                    const int rowb = row - frl;
                    const int b = rowb >> 13, s = (rowb & (SEQ - 1)) + 8 * (frl >> 3);
                    const int cc = col + (b0 ? 4 : 0) + (b1 ? 2 : 0) + (b2 ? 1 : 0);
                    const int head = head0 + cc / DV, dv = cc % DV;
                    constexpr int TL = TLc;
                    u16* o = base + (((size_t)(b * 4 + head) * (SEQ / TL) + s / TL) * DV + dv) * TL + (s % TL);
                    *(u32x4*)o = G;
                } else {
#pragma unroll
                    for (int e = 0; e < 8; ++e) {
                        if (MODE == 3) v[e] = siluf_(v[e]);
                        if (MODE == 6) v[e] = v[e] * frcp(1.f + __expf(-v[e]));
                        if (MODE == 7) v[e] = frcp(1.f + __expf(-v[e]));
                        if (MODE == 4) v[e] *= QSCALE;
                        if (MODE == 5) v[e] = sigmoidf_(v[e]);
                    }
                    u32x4 w = {pk2(v[0], v[1]), pk2(v[2], v[3]), pk2(v[4], v[5]), pk2(v[6], v[7])};
                    if (NT) __builtin_nontemporal_store(w, (u32x4*)(base + (size_t)row * ld + col));
                    else *(u32x4*)(base + (size_t)row * ld + col) = w;
                    if (NRM) {
                        float ssq = 0.f;
#pragma unroll
                        for (int e = 0; e < 4; ++e) { const float lo = bflo(w[e]), hi = bfhi(w[e]); ssq += lo * lo + hi * hi; }
                        ssq = xsum<16>(ssq); ssq = xsum<32>(ssq);
                        rmax[bj] = fmaxf(rmax[bj], ssq);
                    }
                }
            }
        }
    if (NRM) {
#pragma unroll
        for (int bj = 0; bj < 2; ++bj) {
            float mm = rmax[bj];
            mm = xmax<1>(mm); mm = xmax<2>(mm); mm = xmax<4>(mm); mm = xmax<8>(mm);
            if (lane_id_raw() == 0) {
                const int b = row0 >> 13, head = ((col0 >> 8) & 1) * 2 + bj, wcw = (col0 >> 5) & 3;
                atomicMax(qkm + ((b * 4 + head) * 4 + wcw), __float_as_uint(mm));
            }
        }
    }
}

struct EpiIn0 {
    static constexpr bool PERM = true;
    u16* P; const float* LB; unsigned* QKM;
    DI void operator()(const f32x4 (&acc)[2][2][4][2], const pg8::Unit& u, int wr, int wc, int fr, int fq) const {
        const int slot = u.pn >> 1;
        const int row0 = u.pm * 256 + wr * 64 + fr;
        const int col0 = (u.pn & 1) * 256 + wc * 32 + 8 * fq;
        u16* base = P + (size_t)slot * REG;
        switch (slot) {
            case 0: epi_store<0>(acc, base, 512, row0, col0, nullptr, 0); break;
            case 1: epi_store<1>(acc, base, 512, row0, col0, LB, 0); break;
            case 2: epi_store<2, 128, 32>(acc, base, 32, row0, col0, nullptr, 0); break;
            case 3: epi_store<6>(acc, base, 512, row0, col0, nullptr, 0); break;
            case 4: epi_store<4, 128, 64, 1>(acc, base, 512, row0, col0, nullptr, 0, QKM); break;
            case 5: epi_store<0, 128, 64, 1>(acc, base, 512, row0, col0, nullptr, 0, QKM + 64); break;
            case 6: epi_store<2, 128, 64>(acc, base, 64, row0, col0, nullptr, 0); break;
            default: epi_store<6>(acc, base, 512, row0, col0, nullptr, 0); break;
        }
    }
};
struct EpiIn1 {
    static constexpr bool PERM = true;
    u16* P;
    DI void operator()(const f32x4 (&acc)[2][2][4][2], const pg8::Unit& u, int wr, int wc, int fr, int fq) const {
        const int pn = u.pn;
        const int row0 = u.pm * 256 + wr * 64 + fr;
        const int cw = wc * 32 + 8 * fq;
        switch (pn >> 2) {
            case 0: if (pn < 2) epi_store<0>(acc, P, 512, row0, (pn & 1) * 256 + cw, nullptr, 0); else epi_store<0, 128, 64, 0, 0>(acc, P + REG, 512, row0, (pn & 1) * 256 + cw, nullptr, 0); break;
            case 1: epi_store<2, 256, 64>(acc, P + 2 * REG, 64, row0, cw, nullptr, pn - 4); break;
            case 2: epi_store<7>(acc, P + 4 * REG, 1024, row0, (pn - 8) * 256 + cw, nullptr, 0); break;
            default: epi_store<6>(acc, P + 6 * REG, 1024, row0, (pn - 12) * 256 + cw, nullptr, 0); break;
        }
    }
};
template <bool ZB16> struct EpiOut {
    static constexpr bool PERM = true;
    const u16* res; float* Z;
    DI void operator()(const f32x4 (&acc)[2][2][4][2], const pg8::Unit& u, int wr, int wc, int fr, int fq) const {
        const int row0 = u.pm * 256 + wr * 64 + fr, col0 = u.pn * 256 + wc * 32 + 8 * fq;
#pragma unroll
        for (int ai = 0; ai < 2; ++ai) {
            u32x4 r8[4][2];
#pragma unroll
            for (int m = 0; m < 4; ++m)
#pragma unroll
                for (int bj = 0; bj < 2; ++bj) r8[m][bj] = *(const u32x4*)(res + (size_t)(row0 + ai * 128 + m * 16) * 1024 + col0 + bj * 128);
#pragma unroll
            for (int m = 0; m < 4; ++m)
#pragma unroll
                for (int bj = 0; bj < 2; ++bj) {
                    const u32x4 rr = r8[m][bj];
                    f32x4 z0 = {bflo(rr[0]), bfhi(rr[0]), bflo(rr[1]), bfhi(rr[1])}, z1 = {bflo(rr[2]), bfhi(rr[2]), bflo(rr[3]), bfhi(rr[3])};
                    const size_t zo = (size_t)(row0 + ai * 128 + m * 16) * 1024 + col0 + bj * 128;
                    z0 = z0 * ALPHA_RES + acc[ai][bj][m][0]; z1 = z1 * ALPHA_RES + acc[ai][bj][m][1];
                    if (ZB16) { u32x4 w = {pk2(z0[0], z0[1]), pk2(z0[2], z0[3]), pk2(z1[0], z1[1]), pk2(z1[2], z1[3])}; *(u32x4*)(const_cast<u16*>(res) + zo) = w; }
                    else { *(f32x4*)(Z + zo) = z0; *(f32x4*)(Z + zo + 4) = z1; }
                }
        }
    }
};

DI void transpose_w(const float* src, int ld, int cut, int shift, u16* dst, int N, int tile, float* tl) {
    const int nN = N / 64; const int kt = tile / nN, nt = tile % nN; const int k0 = kt * 64, n0 = nt * 64;
    const int tid = ltid();
    const int nsft = n0 >= cut ? shift : 0;
    f32x4 ld4[2];
#pragma unroll
    for (int i = 0; i < 2; ++i) { const int id = tid + 512 * i; const int kk = id >> 4, c4 = id & 15; ld4[i] = __builtin_nontemporal_load((const f32x4*)(src + (size_t)(k0 + kk) * ld + n0 + nsft + 4 * c4)); }
#pragma unroll
    for (int i = 0; i < 2; ++i) { const int id = tid + 512 * i; const int kk = id >> 4, c4 = id & 15; *(f32x4*)(tl + kk * 68 + ((4 * c4 + 4 * (kk >> 3)) & 63)) = ld4[i]; }
    __syncthreads();
    const int nn = tid >> 3, kc = tid & 7;
    float v[8];
#pragma unroll
    for (int e = 0; e < 8; ++e) v[e] = tl[(8 * kc + e) * 68 + ((nn + 4 * kc) & 63)];
    u32x4 w = {pk2(v[0], v[1]), pk2(v[2], v[3]), pk2(v[4], v[5]), pk2(v[6], v[7])};
    *(u32x4*)(dst + (size_t)(n0 + nn) * 1024 + k0 + 8 * kc) = w;
    __syncthreads();
}

DI void phase_prep(const Params& p, unsigned char* lds) {
    float* tl = (float*)lds;
    const int tid = ltid(), wid = tid >> 6, lane = tid & 63;
    for (int t = blockIdx.x; t < 2560; t += gridDim.x) {
        if (t < 1024) transpose_w(p.ab_w_in, 4100, 3584, 4, p.W0T, 4096, t, tl);
        else if (t < 2048) transpose_w(p.c_w_in, 4104, 2048, 8, p.W1T, 4096, t - 1024, tl);
        else if (t < 2304) transpose_w(p.ab_w_out, 1024, 1 << 30, 0, p.W0oT, 1024, t - 2048, tl);
        else transpose_w(p.c_w_out, 1024, 1 << 30, 0, p.W1oT, 1024, t - 2304, tl);
    }
    if (blockIdx.x == 0) {
        if (tid < 512) {
            const float a0 = p.lb_logits[tid], a1 = p.lb_logits[512 + tid], a2 = p.lb_logits[1024 + tid];
            const float mx = fmaxf(a0, fmaxf(a1, a2));
            const float e0 = expf(a0 - mx), e1 = expf(a1 - mx), e2 = expf(a2 - mx);
            p.LB[tid] = e0 / (e0 + e1 + e2);
        }
        if (tid < 128) p.QKM[tid] = 0u;
    }
    float* gw = (float*)lds;
    __syncthreads();
    for (int i = tid; i < 1024; i += 512) *(f32x4*)(gw + ((i & 3) * 256 + (i >> 2)) * 4) = *(const f32x4*)(p.ab_w_in + (size_t)i * 4100 + 3584);
    __syncthreads();
    const float b0 = p.ab_fox_bf[0], b1 = p.ab_fox_bf[1], b2 = p.ab_fox_bf[2], b3 = p.ab_fox_bf[3];
    for (int row0 = (blockIdx.x * 8 + wid) * 4; row0 < T; row0 += gridDim.x * 32) {
        f32x4 xv[4][4];
#pragma unroll
        for (int rr = 0; rr < 4; ++rr)
#pragma unroll
            for (int i = 0; i < 4; ++i) xv[rr][i] = __builtin_nontemporal_load((const f32x4*)(p.x + (size_t)(row0 + rr) * 1024 + 256 * i + 4 * lane));
        float d[16];
#pragma unroll
        for (int e = 0; e < 16; ++e) d[e] = 0.f;
#pragma unroll
        for (int i = 0; i < 4; ++i) {
            const int c = 256 * i + 4 * lane;
#pragma unroll
            for (int e = 0; e < 4; ++e) {
                const f32x4 g = *(const f32x4*)(gw + (e * 256 + 64 * i + lane) * 4);
#pragma unroll
                for (int rr = 0; rr < 4; ++rr) { const float xe = xv[rr][i][e]; d[4 * rr + 0] += xe * g[0]; d[4 * rr + 1] += xe * g[1]; d[4 * rr + 2] += xe * g[2]; d[4 * rr + 3] += xe * g[3]; }
            }
        }
#pragma unroll
        for (int rr = 0; rr < 4; ++rr)
#pragma unroll
            for (int i = 0; i < 4; ++i) { u32x2 w = {pk2(xv[rr][i][0], xv[rr][i][1]), pk2(xv[rr][i][2], xv[rr][i][3])}; *(u32x2*)(p.X16 + (size_t)(row0 + rr) * 1024 + 256 * i + 4 * lane) = w; }
        {
            const float tot = wave_reduce16(d, lane);
            const int j = lane >> 2;
            const int g = j & 3;
            const float bb = g == 0 ? b0 : (g == 1 ? b1 : (g == 2 ? b2 : b3));
            if ((lane & 3) == 0) p.LF[(size_t)(row0 + (j >> 2)) * 4 + g] = log_sigmoid(tot + bb);
        }
    }
}

template <bool GATES>
DI void phase_ln(const Params& p, int layer, unsigned char* lds) {
    const int tid = ltid(), wid = tid >> 6, lane = tid & 63;
    float* gw = (float*)lds;
    if (GATES) {
        __syncthreads();
        for (int i = tid; i < 2048; i += 512) { const int k = i >> 1, hf = i & 1; const int idx = (k & 3) * 256 + (k >> 2); *(f32x4*)(gw + hf * 4096 + idx * 4) = *(const f32x4*)(p.c_w_in + (size_t)k * 4104 + 2048 + hf * 4); }
        __syncthreads();
    }
    const float* lg = p.ln_g + layer * 1024; const float* lbv = p.ln_b + layer * 1024;
    f32x4 g4[4], b4[4];
#pragma unroll
    for (int i = 0; i < 4; ++i) { g4[i] = *(const f32x4*)(lg + 256 * i + 4 * lane); b4[i] = *(const f32x4*)(lbv + 256 * i + 4 * lane); }
    constexpr int R = GATES ? 2 : 4;
    for (int row0 = (blockIdx.x * 8 + wid) * R; row0 < T; row0 += gridDim.x * 8 * R) {
        f32x4 v[R][4]; float s[R];
#pragma unroll
        for (int rr = 0; rr < R; ++rr) {
            s[rr] = 0.f;
#pragma unroll
            for (int i = 0; i < 4; ++i) {
                if (GATES) { const u32x2 zb = *(const u32x2*)(p.X16 + (size_t)(row0 + rr) * 1024 + 256 * i + 4 * lane); v[rr][i] = (f32x4){bflo(zb[0]), bfhi(zb[0]), bflo(zb[1]), bfhi(zb[1])}; }
                else v[rr][i] = *(const f32x4*)(p.out + (size_t)(row0 + rr) * 1024 + 256 * i + 4 * lane);
            }
        }
#pragma unroll
        for (int rr = 0; rr < R; ++rr)
#pragma unroll
            for (int i = 0; i < 4; ++i) s[rr] += v[rr][i][0] + v[rr][i][1] + v[rr][i][2] + v[rr][i][3];
        wave_sum_n<R>(s);
        float q[R];
#pragma unroll
        for (int rr = 0; rr < R; ++rr) {
            s[rr] *= (1.f / 1024.f); q[rr] = 0.f;
#pragma unroll
            for (int i = 0; i < 4; ++i)
#pragma unroll
                for (int e = 0; e < 4; ++e) { const float dd = v[rr][i][e] - s[rr]; q[rr] += dd * dd; }
        }
        wave_sum_n<R>(q);
#pragma unroll
        for (int rr = 0; rr < R; ++rr) {
            const float rstd = rsqrtf(q[rr] * (1.f / 1024.f) + 1e-5f);
#pragma unroll
            for (int i = 0; i < 4; ++i)
#pragma unroll
                for (int e = 0; e < 4; ++e) v[rr][i][e] = (v[rr][i][e] - s[rr]) * rstd * g4[i][e] + b4[i][e];
        }
#pragma unroll
        for (int rr = 0; rr < R; ++rr)
#pragma unroll
            for (int i = 0; i < 4; ++i) {
                const int c = 256 * i + 4 * lane;
                if (!GATES) __builtin_nontemporal_store(v[rr][i], (f32x4*)(p.out + (size_t)(row0 + rr) * 1024 + c));
                if (GATES) { u32x2 w = {pk2(v[rr][i][0], v[rr][i][1]), pk2(v[rr][i][2], v[rr][i][3])}; *(u32x2*)(p.X16 + (size_t)(row0 + rr) * 1024 + c) = w; }
            }
        if (GATES) {
            float d[16];
#pragma unroll
            for (int e = 0; e < 16; ++e) d[e] = 0.f;
#pragma unroll
            for (int i = 0; i < 4; ++i)
#pragma unroll
                for (int e = 0; e < 4; ++e) {
                    const int idx = e * 256 + 64 * i + lane;
                    const f32x4 ga = *(const f32x4*)(gw + idx * 4), gb = *(const f32x4*)(gw + 4096 + idx * 4);
#pragma unroll
                    for (int r2 = 0; r2 < 2; ++r2) {
                        const float y = v[r2 < R ? r2 : 0][i][e];
                        d[8 * r2 + 0] += y * ga[0]; d[8 * r2 + 1] += y * ga[1]; d[8 * r2 + 2] += y * ga[2]; d[8 * r2 + 3] += y * ga[3];
                        d[8 * r2 + 4] += y * gb[0]; d[8 * r2 + 5] += y * gb[1]; d[8 * r2 + 6] += y * gb[2]; d[8 * r2 + 7] += y * gb[3];
                    }
                }
            {
                const float tot = wave_reduce16(d, lane);
                const int j = lane >> 2, r2 = j >> 3, g = j & 7, gi = g & 3;
                if ((lane & 3) == 0) {
                    const size_t row = (size_t)(row0 + r2);
                    const float bias = g < 4 ? p.c_bi[gi] : p.c_bf[gi];
                    if (g < 4) p.IG[row * 4 + gi] = tot + bias; else p.FG[row * 4 + gi] = log_sigmoid(tot + bias);
                }
            }
        }
    }
}

DI void phase_foxprep(const Params& p, unsigned char* lds) {
    const int tid = ltid(), wid = tid >> 6, lane = tid & 63;
    const u16* FQ = p.P + 4 * REG; const u16* FK = p.P + 5 * REG;
    if (blockIdx.x < 16) {
        float* wt = (float*)lds;
        const int bh = blockIdx.x, b = bh >> 2, head = bh & 3;
        float loc[16]; float run = 0.f;
#pragma unroll
        for (int i = 0; i < 16; ++i) { run += p.LF[((size_t)b * SEQ + 16 * tid + i) * 4 + head]; loc[i] = run; }
        float inc = run;
#pragma unroll
        for (int o = 1; o < 64; o <<= 1) { const float t = __shfl_up(inc, o); if (lane >= o) inc += t; }
        __syncthreads();
        if (lane == 63) wt[wid] = inc;
        __syncthreads();
        float off = 0.f;
        for (int w = 0; w < wid; ++w) off += wt[w];
        const float ex = inc - run + off;
#pragma unroll
        for (int i = 0; i < 16; ++i) p.CS[(size_t)bh * SEQ + 16 * tid + i] = ex + loc[i];
        __syncthreads();
    }
}

template <bool OUT>
DI void hgrn_item(const Params& p, int item, unsigned char* lds) {
    const int tid = ltid(), lane = tid & 63, r = lane & 31, h = lane >> 5;
    const int grp = tid >> 8, gt = tid & 255, gw = (tid >> 6) & 3;
    const int b = item >> 6, hp = (item >> 5) & 1, j = item & 31;
    const int head = hp * 2 + grp, bh = b * 4 + head;
    unsigned char* L = lds + grp * 63488;
    u16* Graw = (u16*)(L + 46080); u16* Qraw = (u16*)(L + 54784);
    float* gnl = (float*)(lds + 126976 + grp * 512);
    u16* Qd = (u16*)L; u16* Ki = (u16*)(L + 8704); u16* KeT = (u16*)(L + 17408);
    float* Dk = (float*)(L + 27648); float* hs = (float*)(L + 28160); float* Ost = (float*)(L + 29184);
    const u16* HQ = p.P; const u16* HG = p.P + REG; const u16* HVT = p.P + 2 * REG; const u16* HZ = p.P + 3 * REG;
    f32x16 St[4];
    if (OUT && j > 0) {
        const float* src = p.HS + ((size_t)(bh * 32 + j - 1) << 14);
#pragma unroll
        for (int kt = 0; kt < 4; ++kt)
#pragma unroll
            for (int q4 = 0; q4 < 4; ++q4) { const f32x4 t4 = *(const f32x4*)(src + ((gw * 4 + kt) * 4 + q4) * 256 + lane * 4);
#pragma unroll
                for (int i = 0; i < 4; ++i) St[kt][4 * q4 + i] = t4[i]; }
    } else {
#pragma unroll
        for (int kt = 0; kt < 4; ++kt) St[kt] = zero16();
    }
    float logD0 = 0.f, logD1 = 0.f;
    const int kp = gt & 63, tg = gt >> 6;
    float* hs4 = (float*)(lds + 128000 + grp * 2048);
    if (OUT && gt < 128) gnl[gt] = p.ab_norm_g[head * 128 + gt];
    u32x4 gpre[2], qpre[2]; bf16x8 vpre[2]; s16x4 vppre[2][2];
    {
        const size_t rb0 = (size_t)b * SEQ + j * 256;
        const u16* vr0 = HVT + (((size_t)bh * 256 + ((j * 256) >> 5)) * 128 + 32 * gw + r) * 32;
#pragma unroll
        for (int i = 0; i < 2; ++i) {
            const int id = gt + 256 * i; const size_t go = (rb0 + (id >> 4)) * 512 + head * 128 + (id & 15) * 8;
            gpre[i] = *(const u32x4*)(HG + go); if (OUT) qpre[i] = *(const u32x4*)(HQ + go);
            vpre[i] = *(const bf16x8*)(vr0 + 16 * i + 8 * h);
            if (OUT) { vppre[i][0] = *(const s16x4*)(vr0 + 16 * i + 4 * h); vppre[i][1] = *(const s16x4*)(vr0 + 16 * i + 8 + 4 * h); }
        }
    }
    for (int c = 0; c < 8; ++c) {
        const int s0 = j * 256 + c * 32; const size_t rowbase = (size_t)b * SEQ + s0;
        const u16* vrow = HVT + (((size_t)bh * 256 + (s0 >> 5)) * 128 + 32 * gw + r) * 32;
        bf16x8 vn[2]; s16x4 vp[2][2];
#pragma unroll
        for (int i = 0; i < 2; ++i) {
            const int id = gt + 256 * i;
            *(u32x4*)(Graw + (id >> 4) * 136 + (id & 15) * 8) = gpre[i];
            if (OUT) *(u32x4*)(Qraw + (id >> 4) * 136 + (id & 15) * 8) = qpre[i];
            vn[i] = vpre[i];
            if (OUT) { vp[i][0] = vppre[i][0]; vp[i][1] = vppre[i][1]; }
        }
        if (c < 7) {
            const u16* vr1 = vrow + 128 * 32;
#pragma unroll
            for (int i = 0; i < 2; ++i) {
                const int id = gt + 256 * i; const size_t go = (rowbase + 32 + (id >> 4)) * 512 + head * 128 + (id & 15) * 8;
                gpre[i] = *(const u32x4*)(HG + go); if (OUT) qpre[i] = *(const u32x4*)(HQ + go);
                vpre[i] = *(const bf16x8*)(vr1 + 16 * i + 8 * h);
                if (OUT) { vppre[i][0] = *(const s16x4*)(vr1 + 16 * i + 4 * h); vppre[i][1] = *(const s16x4*)(vr1 + 16 * i + 8 + 4 * h); }
            }
        }
        __syncthreads();
        float g0[8], g1[8], q0[8], q1[8], c0[8], c1[8];
#pragma unroll
        for (int i = 0; i < 8; ++i) {
            const unsigned gw2 = *(const unsigned*)(Graw + (8 * tg + i) * 136 + 2 * kp);
            g0[i] = h2f((u16)(gw2 & 0xffffu)); g1[i] = h2f((u16)(gw2 >> 16));
            if (OUT) { const unsigned qw2 = *(const unsigned*)(Qraw + (8 * tg + i) * 136 + 2 * kp); q0[i] = bflo(qw2); q1[i] = bfhi(qw2); }
        }
        float run0 = 0.f, run1 = 0.f;
#pragma unroll
        for (int i = 0; i < 8; ++i) { run0 += g0[i]; c0[i] = run0; run1 += g1[i]; c1[i] = run1; }
        *(f32x2*)(hs4 + tg * 128 + 2 * kp) = (f32x2){run0, run1};
        __syncthreads();
        float off0 = 0.f, off1 = 0.f, bl0 = 0.f, bl1 = 0.f;
#pragma unroll
        for (int t4 = 0; t4 < 4; ++t4) { const f32x2 hv = *(const f32x2*)(hs4 + t4 * 128 + 2 * kp); bl0 += hv[0]; bl1 += hv[1]; if (t4 < tg) { off0 += hv[0]; off1 += hv[1]; } }
        const float D0 = __expf(bl0), D1 = __expf(bl1);
        float ke0[8], ke1[8];
#pragma unroll
        for (int i = 0; i < 8; ++i) {
            const float bb0 = c0[i] + off0, bb1 = c1[i] + off1;
            const float kk0 = 1.f - __expf(g0[i]), kk1 = 1.f - __expf(g1[i]);
            const float ki0 = kk0 * __expf(-bb0), ki1 = kk1 * __expf(-bb1);
            ke0[i] = ki0 * D0; ke1[i] = ki1 * D1;
            if (OUT) {
                *(unsigned*)(Qd + (8 * tg + i) * 136 + 2 * kp) = pk2(q0[i] * __expf(bb0), q1[i] * __expf(bb1));
                *(unsigned*)(Ki + (8 * tg + i) * 136 + 2 * kp) = pk2(ki0, ki1);
            }
        }
        { u32x4 w0 = {pk2(ke0[0], ke0[1]), pk2(ke0[2], ke0[3]), pk2(ke0[4], ke0[5]), pk2(ke0[6], ke0[7])}, w1 = {pk2(ke1[0], ke1[1]), pk2(ke1[2], ke1[3]), pk2(ke1[4], ke1[5]), pk2(ke1[6], ke1[7])};
          *(u32x4*)(KeT + (2 * kp) * 40 + 8 * tg) = w0; *(u32x4*)(KeT + (2 * kp + 1) * 40 + 8 * tg) = w1; }
        if (tg == 0) { *(f32x2*)(Dk + 2 * kp) = (f32x2){D0, D1}; logD0 += bl0; logD1 += bl1; }
        __syncthreads();
        f32x16 o;
        if (OUT) {
            f32x16 aT = zero16();
#pragma unroll
            for (int ks = 0; ks < 8; ++ks) { const bf16x8 A = *(const bf16x8*)(Ki + r * 136 + 16 * ks + 8 * h), B = *(const bf16x8*)(Qd + r * 136 + 16 * ks + 8 * h); aT = MFMA32(A, B, aT); }
#pragma unroll
            for (int rg = 0; rg < 16; ++rg) if (crow(rg, h) > r) aT[rg] = 0.f;
            const bf16x8 PA0 = pack8<0>(aT), PA1 = pack8<8>(aT);
            o = zero16();
            o = MFMA32(PA0, join4(vp[0][0], vp[0][1]), o);
            o = MFMA32(PA1, join4(vp[1][0], vp[1][1]), o);
#pragma unroll
            for (int kt = 0; kt < 4; ++kt) {
                { const bf16x8 Bs = pack8<0>(St[kt]);
                  const s16x4 lo = *(const s16x4*)(Qd + r * 136 + 32 * kt + 4 * h), hi = *(const s16x4*)(Qd + r * 136 + 32 * kt + 8 + 4 * h);
                  o = MFMA32(join4(lo, hi), Bs, o); }
                { const bf16x8 Bs = pack8<8>(St[kt]);
                  const s16x4 lo = *(const s16x4*)(Qd + r * 136 + 32 * kt + 16 + 4 * h), hi = *(const s16x4*)(Qd + r * 136 + 32 * kt + 24 + 4 * h);
                  o = MFMA32(join4(lo, hi), Bs, o); }
            }
        }
#pragma unroll
        for (int kt = 0; kt < 4; ++kt) {
#pragma unroll
            for (int gg = 0; gg < 4; ++gg) { const f32x4 dk = *(const f32x4*)(Dk + 32 * kt + 8 * gg + 4 * h);
#pragma unroll
                for (int i = 0; i < 4; ++i) St[kt][4 * gg + i] *= dk[i]; }
#pragma unroll
            for (int sp = 0; sp < 2; ++sp) { const bf16x8 A = *(const bf16x8*)(KeT + (32 * kt + r) * 40 + 16 * sp + 8 * h); St[kt] = MFMA32(A, vn[sp], St[kt]); }
        }
        if (OUT) {
#pragma unroll
            for (int rg = 0; rg < 16; ++rg) Ost[crow(rg, h) * 132 + 32 * gw + r] = o[rg];
            __syncthreads();
            const int t = gt >> 3, seg = gt & 7;
            f32x4 xv[4]; float ss = 0.f;
#pragma unroll
            for (int i = 0; i < 4; ++i) { xv[i] = *(const f32x4*)(Ost + t * 132 + 16 * seg + 4 * i); ss += xv[i][0] * xv[i][0] + xv[i][1] * xv[i][1] + xv[i][2] * xv[i][2] + xv[i][3] * xv[i][3]; }
            ss = xsum<1>(ss); ss = xsum<2>(ss); ss = xsum<4>(ss);
            const float rs = rsqrtf(ss * (1.f / 128.f) + 1e-6f);
            const size_t row = rowbase + t; const int col = head * 128 + 16 * seg;
            const u32x4 z0 = *(const u32x4*)(HZ + row * 512 + col), z1 = *(const u32x4*)(HZ + row * 512 + col + 8);
            float ov[16];
#pragma unroll
            for (int i = 0; i < 4; ++i) { const f32x4 gn = *(const f32x4*)(gnl + 16 * seg + 4 * i);
#pragma unroll
                for (int e = 0; e < 4; ++e) ov[4 * i + e] = xv[i][e] * rs * gn[e]; }
#pragma unroll
            for (int e = 0; e < 4; ++e) { ov[2 * e] *= bflo(z0[e]); ov[2 * e + 1] *= bfhi(z0[e]); ov[8 + 2 * e] *= bflo(z1[e]); ov[8 + 2 * e + 1] *= bfhi(z1[e]); }
            u32x4 w0 = {pk2(ov[0], ov[1]), pk2(ov[2], ov[3]), pk2(ov[4], ov[5]), pk2(ov[6], ov[7])}, w1 = {pk2(ov[8], ov[9]), pk2(ov[10], ov[11]), pk2(ov[12], ov[13]), pk2(ov[14], ov[15])};
            *(u32x4*)(p.M + row * 1024 + col) = w0; *(u32x4*)(p.M + row * 1024 + col + 8) = w1;
        }
    }
    if (!OUT) {
        float* dst = p.HS + ((size_t)(bh * 32 + j) << 14);
#pragma unroll
        for (int kt = 0; kt < 4; ++kt)
#pragma unroll
            for (int q4 = 0; q4 < 4; ++q4) { f32x4 t4 = {St[kt][4 * q4], St[kt][4 * q4 + 1], St[kt][4 * q4 + 2], St[kt][4 * q4 + 3]};
                *(f32x4*)(dst + ((gw * 4 + kt) * 4 + q4) * 256 + lane * 4) = t4; }
        if (tg == 0) *(f32x2*)(p.HD + (size_t)(bh * 32 + j) * 128 + 2 * kp) = (f32x2){__expf(logD0), __expf(logD1)};
    }
    __syncthreads();
}

DI void hgrn_scan(const Params& p) {
    for (int e = blockIdx.x * 512 + ltid(); e < 16 * 4096; e += gridDim.x * 512) {
        const int bh = e >> 12, qd = e & 4095;
        const int ln = qd & 63, q4 = (qd >> 6) & 3, kt = (qd >> 8) & 3;
        const int k0 = 32 * kt + 8 * q4 + 4 * (ln >> 5);
        f32x4 s = {0.f, 0.f, 0.f, 0.f};
#pragma unroll
        for (int hb = 0; hb < 2; ++hb) {
            const int j0 = hb * 16, nj = hb ? 15 : 16;
            f32x4 u[16], d[16];
#pragma unroll
            for (int jj = 0; jj < 16; ++jj) if (jj < nj) { u[jj] = *(const f32x4*)(p.HS + ((size_t)(bh * 32 + j0 + jj) << 14) + qd * 4); d[jj] = *(const f32x4*)(p.HD + (size_t)(bh * 32 + j0 + jj) * 128 + k0); }
#pragma unroll
            for (int jj = 0; jj < 16; ++jj) if (jj < nj) { s = d[jj] * s + u[jj]; u[jj] = s; }
#pragma unroll
            for (int jj = 0; jj < 16; ++jj) if (jj < nj) *(f32x4*)(p.HS + ((size_t)(bh * 32 + j0 + jj) << 14) + qd * 4) = u[jj];
        }
    }
}

DI void fox_item(const Params& p, int item, unsigned char* lds) {
    const int tid = ltid(), wid = __builtin_amdgcn_readfirstlane(tid >> 6), lane = tid & 63, r = lane & 31, h = lane >> 5;
    const int bid8 = item & 255, rnd = item >> 8;
    const int bh = 2 * (bid8 & 7) + rnd, qb = 31 - (bid8 >> 3), b = bh >> 2, head = bh & 3;
    const int t0 = qb * 256;
    const u16* FQ = p.P + 4 * REG; const u16* FK = p.P + 5 * REG; const u16* FVT = p.P + 6 * REG; const u16* FZ = p.P + 7 * REG;
    const float* CSb = p.CS + (size_t)bh * SEQ;
    int* misc = (int*)(lds + 72192);
    const int jd = qb * 4 + 3;
    const int tq = t0 + 32 * wid + r;
    const size_t row_t = (size_t)b * SEQ + tq;
    bf16x8 qf[8];
#pragma unroll
    for (int ks = 0; ks < 8; ++ks) qf[ks] = *(const bf16x8*)(FQ + row_t * 512 + head * 128 + 16 * ks + 8 * h);
    const float ct = CSb[tq];
    float m = -1e30f, l = 0.f;
    f32x16 O[4];
#pragma unroll
    for (int mt = 0; mt < 4; ++mt) O[mt] = zero16();
    u32x4 kreg[2], vreg[2]; float creg = 0.f;
    const int kr0 = tid >> 4, kc = tid & 15, vr0 = tid >> 3, vc = tid & 7;
    auto gload = [&](int jt) {
#pragma unroll
        for (int i = 0; i < 2; ++i) {
            kreg[i] = *(const u32x4*)(FK + ((size_t)b * SEQ + 64 * jt + kr0 + 32 * i) * 512 + head * 128 + kc * 8);
            vreg[i] = *(const u32x4*)(FVT + (((size_t)bh * 128 + jt) * 128 + vr0 + 64 * i) * 64 + vc * 8);
        }
        if (tid < 64) creg = CSb[64 * jt + tid];
    };
    auto lwrite = [&](int buf) {
        u16* Kt = (u16*)(lds + buf * 17408); u16* Vt = (u16*)(lds + 34816 + buf * 18432); float* cs = (float*)(lds + 71680 + buf * 256);
#pragma unroll
        for (int i = 0; i < 2; ++i) {
            *(u32x4*)(Kt + (kr0 + 32 * i) * 136 + kc * 8) = kreg[i];
            *(u32x4*)(Vt + (vr0 + 64 * i) * 72 + vc * 8) = vreg[i];
        }
        if (tid < 64) cs[tid] = creg;
    };
    gload(jd);
    const float bq = __uint_as_float(p.QKM[bh * 4]) + __uint_as_float(p.QKM[bh * 4 + 1]) + __uint_as_float(p.QKM[bh * 4 + 2]) + __uint_as_float(p.QKM[bh * 4 + 3]);
    const float bk = __uint_as_float(p.QKM[64 + bh * 4]) + __uint_as_float(p.QKM[64 + bh * 4 + 1]) + __uint_as_float(p.QKM[64 + bh * 4 + 2]) + __uint_as_float(p.QKM[64 + bh * 4 + 3]);
    const float bound = 2.f * sqrtf(bq * bk) * 1.01f + 106.f;
    const float ct0 = CSb[t0];
    float cprobe = 0.f;
    if (tid < 128 && tid < qb * 4) cprobe = CSb[64 * tid + 63];
    __syncthreads();
    if (tid == 0) misc[0] = 0;
    __syncthreads();
    if (tid < 128 && tid < qb * 4) { if (cprobe - ct0 > bound) atomicMax(misc, tid + 1); }
    lwrite(0);
    __syncthreads();
    const int j_lo = misc[0];
    int buf = 0;
    for (int jt = jd; jt >= j_lo; --jt) {
        if (jt > j_lo) gload(jt - 1);
        if (64 * jt <= t0 + 32 * wid + 31) {
            const u16* Kt = (const u16*)(lds + buf * 17408); const u16* Vt = (const u16*)(lds + 34816 + buf * 18432); const float* cs = (const float*)(lds + 71680 + buf * 256);
            f32x16 sT[2];
            __builtin_amdgcn_s_setprio(1);
            const bool live1 = (64 * jt + 32 <= t0 + 32 * wid + 31);
#pragma unroll
            for (int kt = 0; kt < 2; ++kt) {
                sT[kt] = zero16();
                if (kt == 0 || live1) {
#pragma unroll
                    for (int ks = 0; ks < 8; ++ks) { const bf16x8 A = *(const bf16x8*)(Kt + (32 * kt + r) * 136 + 16 * ks + 8 * h); sT[kt] = MFMA32(A, qf[ks], sT[kt]); }
                }
            }
            __builtin_amdgcn_s_setprio(0);
            const bool needmask = (64 * jt + 63 > t0 + 32 * wid);
            float mx = -__builtin_inff();
#pragma unroll
            for (int kt = 0; kt < 2; ++kt)
#pragma unroll
                for (int gg = 0; gg < 4; ++gg) {
                    const f32x4 cc = *(const f32x4*)(cs + 32 * kt + 8 * gg + 4 * h);
#pragma unroll
                    for (int i = 0; i < 4; ++i) {
                        float v = sT[kt][4 * gg + i] + (ct - cc[i]);
                        if (needmask) { const int key = 64 * jt + 32 * kt + 8 * gg + 4 * h + i; if (key > tq) v = -__builtin_inff(); }
                        sT[kt][4 * gg + i] = v; mx = fmaxf(mx, v);
                    }
                }
            mx = xmax<32>(mx);
            const float mn = fmaxf(m, mx);
            const float alpha = __expf(m - mn); m = mn;
            float ps = 0.f;
#pragma unroll
            for (int kt = 0; kt < 2; ++kt)
#pragma unroll
                for (int rg = 0; rg < 16; ++rg) { const float pv = __expf(sT[kt][rg] - mn); sT[kt][rg] = pv; ps += pv; }
            ps = xsum<32>(ps);
            l = l * alpha + ps;
            if (__any(alpha != 1.f)) {
#pragma unroll
                for (int mt = 0; mt < 4; ++mt)
#pragma unroll
                    for (int rg = 0; rg < 16; ++rg) O[mt][rg] *= alpha;
            }
            const bf16x8 PB00 = pack8<0>(sT[0]), PB01 = pack8<8>(sT[0]), PB10 = pack8<0>(sT[1]), PB11 = pack8<8>(sT[1]);
            __builtin_amdgcn_s_setprio(1);
#pragma unroll
            for (int mt = 0; mt < 4; ++mt) {
                const u16* vb = Vt + (32 * mt + r) * 72 + 4 * h;
                O[mt] = MFMA32(join4(*(const s16x4*)(vb), *(const s16x4*)(vb + 8)), PB00, O[mt]);
                O[mt] = MFMA32(join4(*(const s16x4*)(vb + 16), *(const s16x4*)(vb + 24)), PB01, O[mt]);
                if (live1) {
                    O[mt] = MFMA32(join4(*(const s16x4*)(vb + 32), *(const s16x4*)(vb + 40)), PB10, O[mt]);
                    O[mt] = MFMA32(join4(*(const s16x4*)(vb + 48), *(const s16x4*)(vb + 56)), PB11, O[mt]);
                }
            }
            __builtin_amdgcn_s_setprio(0);
        }
        if (jt > j_lo) lwrite(buf ^ 1);
        __syncthreads();
        buf ^= 1;
    }
    const float inv = 1.f / l;
    u32x4 zz[4][2];
#pragma unroll
    for (int mt = 0; mt < 4; ++mt)
#pragma unroll
        for (int a2 = 0; a2 < 2; ++a2) zz[mt][a2] = *(const u32x4*)(FZ + row_t * 512 + head * 128 + 32 * mt + 16 * a2 + 8 * h);
#pragma unroll
    for (int mt = 0; mt < 4; ++mt)
#pragma unroll
        for (int a2 = 0; a2 < 2; ++a2) {
            float lo4[4], hi4[4];
#pragma unroll
            for (int i = 0; i < 4; ++i) {
                auto rr = __builtin_amdgcn_permlane32_swap(__float_as_uint(O[mt][8 * a2 + i]), __float_as_uint(O[mt][8 * a2 + 4 + i]), false, false);
                lo4[i] = __uint_as_float(rr[0]); hi4[i] = __uint_as_float(rr[1]);
            }
            const u32x4 z = zz[mt][a2];
            u32x4 w;
            w.x = pk2(lo4[0] * inv * bflo(z[0]), lo4[1] * inv * bfhi(z[0]));
            w.y = pk2(lo4[2] * inv * bflo(z[1]), lo4[3] * inv * bfhi(z[1]));
            w.z = pk2(hi4[0] * inv * bflo(z[2]), hi4[1] * inv * bfhi(z[2]));
            w.w = pk2(hi4[2] * inv * bflo(z[3]), hi4[3] * inv * bfhi(z[3]));
            *(u32x4*)(p.M + row_t * 1024 + 512 + head * 128 + 32 * mt + 16 * a2 + 8 * h) = w;
        }
}

template <bool OUT>
DI void mlstm_item(const Params& p, int item, unsigned char* lds) {
    const int tid = ltid(), wid = __builtin_amdgcn_readfirstlane(tid >> 6), lane = tid & 63, r = lane & 31, h = lane >> 5;
    const int bh = item >> 4, j = item & 15, b = bh >> 2, head = bh & 3;
    u16* Qs = (u16*)lds; u16* Ks = (u16*)(lds + 17408); u16* KwT = (u16*)(lds + 34816);
    float* uS = (float*)(lds + 53248); float* rowA = uS + 64; float* sint = uS + 128; float* nfl = uS + 192; float* wk = uS + 256;
    float* misc = (float*)(lds + 54528);
    float* nf = (float*)(lds + 54592); u16* n16 = (u16*)(lds + 55104); float* npart = (float*)(lds + 55360);
    float* Ost = (float*)(lds + 57408);
    u16* VTs = (u16*)(lds + 123968);
    float* gnl = (float*)(lds + 160832);
    const u16* MQ = p.P; const u16* MK = p.P + REG; const u16* MVT = p.P + 2 * REG; const u16* MO = p.P + 4 * REG; const u16* MZ = p.P + 6 * REG;
    const int slotp = bh * 16 + j - 1;
    f32x16 Ct[4];
    if (OUT && j > 0) {
        const float* src = p.MS + (size_t)slotp * 32768;
#pragma unroll
        for (int kt = 0; kt < 4; ++kt)
#pragma unroll
            for (int q4 = 0; q4 < 4; ++q4) { const f32x4 t4 = *(const f32x4*)(src + ((wid * 4 + kt) * 4 + q4) * 256 + lane * 4);
#pragma unroll
                for (int i = 0; i < 4; ++i) Ct[kt][4 * q4 + i] = t4[i]; }
    } else {
#pragma unroll
        for (int kt = 0; kt < 4; ++kt) Ct[kt] = zero16();
    }
    __syncthreads();
    if (tid < 128) { const float nv = (OUT && j > 0) ? p.MN[(size_t)slotp * 128 + tid] : 0.f; nf[tid] = nv; n16[tid] = f2bf(nv); }
    if (OUT && tid >= 256) gnl[tid - 256] = p.c_norm_g[head * 256 + (tid - 256)];
    float m_prev = OUT ? (j > 0 ? p.MM[slotp] : 0.f) : -1e30f;
    float Bsum = 0.f;
    float my_bc, my_u, my_cm, my_blast, my_cml;
    {
        const size_t grow = (size_t)b * SEQ + j * 512 + wid * 64 + lane;
        const float lf = p.FG[grow * 4 + head], ig = p.IG[grow * 4 + head];
        float bc = lf;
#pragma unroll
        for (int o = 1; o < 64; o <<= 1) { const float t = __shfl_up(bc, o); if (lane >= o) bc += t; }
        const float u = ig - bc;
        float cm = u;
#pragma unroll
        for (int o = 1; o < 64; o <<= 1) { const float t = __shfl_up(cm, o); if (lane >= o) cm = fmaxf(cm, t); }
        my_bc = bc; my_u = u; my_cm = cm;
        my_blast = __shfl(bc, 63); my_cml = __shfl(cm, 63);
        if (lane == 0) misc[4 + wid] = my_blast;
    }
    u32x4 vpre[4], kpre[3], qpre[3];
    {
        const int s00 = j * 512;
#pragma unroll
        for (int i = 0; i < 4; ++i) { const int id = tid + 512 * i; if (!OUT) vpre[i] = *(const u32x4*)(MVT + (((size_t)bh * 128 + (s00 >> 6)) * 256 + (id >> 3)) * 64 + (id & 7) * 8); }
#pragma unroll
        for (int i = 0; i < 3; ++i) { const int id = tid + 512 * i; const int rr = id < 1072 ? (id >> 4) : 0, c16 = id & 15; const int sidx = s00 - 3 + rr;
            const size_t go = ((size_t)b * SEQ + (sidx < 0 ? 0 : sidx)) * 512 + head * 128 + c16 * 8;
            kpre[i] = *(const u32x4*)(MK + go); if (OUT) qpre[i] = *(const u32x4*)(MQ + go); }
    }
#pragma unroll 1
    for (int c = 0; c < 8; ++c) {
        int tl = tid; asm volatile("" : "+v"(tl));
        const int lane = tl & 63, r = lane & 31, h = lane >> 5;
        const int k = tl & 127, tqd = tl >> 7;
        const int colq = head * 128 + k;
        float cwq[4], cwk[4];
#pragma unroll
        for (int e = 0; e < 4; ++e) { cwq[e] = p.c_conv_w[e * 1024 + colq]; cwk[e] = p.c_conv_w[e * 1024 + 512 + colq]; }
        const float cbq = p.c_conv_b[colq], cbk = p.c_conv_b[512 + colq];
        const int s0 = j * 512 + c * 64; const size_t rowbase = (size_t)b * SEQ + s0;
        u32x4 vst[4];
        const u16* vrow = VTs + (32 * wid + r) * 72;
        u16* Kraw = (u16*)Ost; u16* Qraw = (u16*)((unsigned char*)Ost + 18432);
        if (OUT) {
#pragma unroll
            for (int i = 0; i < 4; ++i) { const int id = tl + 512 * i; vst[i] = *(const u32x4*)(MVT + (((size_t)bh * 128 + (s0 >> 6)) * 256 + (id >> 3)) * 64 + (id & 7) * 8); }
        } else {
#pragma unroll
            for (int i = 0; i < 4; ++i) vst[i] = vpre[i];
        }
#pragma unroll
        for (int i = 0; i < 3; ++i) {
            const int id = tl + 512 * i;
            if (id < 1072) {
                const int rr = id >> 4, c16 = id & 15;
                u32x4 kv4 = kpre[i]; u32x4 qv4; if (OUT) qv4 = qpre[i];
                if (s0 - 3 + rr < 0) { kv4 = (u32x4){0u, 0u, 0u, 0u}; if (OUT) qv4 = (u32x4){0u, 0u, 0u, 0u}; }
                *(u32x4*)(Kraw + rr * 136 + c16 * 8) = kv4;
                if (OUT) *(u32x4*)(Qraw + rr * 136 + c16 * 8) = qv4;
            }
        }
        if (!OUT && c < 7) {
            const int s1 = s0 + 64;
#pragma unroll
            for (int i = 0; i < 4; ++i) { const int id = tl + 512 * i; vpre[i] = *(const u32x4*)(MVT + (((size_t)bh * 128 + (s1 >> 6)) * 256 + (id >> 3)) * 64 + (id & 7) * 8); }
#pragma unroll
            for (int i = 0; i < 3; ++i) { const int id = tl + 512 * i; const int rr = id < 1072 ? (id >> 4) : 0, c16 = id & 15;
                kpre[i] = *(const u32x4*)(MK + ((size_t)b * SEQ + (s1 - 3 + rr)) * 512 + head * 128 + c16 * 8); }
        }
        __syncthreads();
        if (wid == c) {
            const float bc = my_bc, u = my_u, cm = my_cm, blast = my_blast, cml = my_cml;
            const float Mx = fmaxf(m_prev, cm);
            uS[lane] = u; rowA[lane] = -Mx; sint[lane] = __expf(m_prev - Mx); nfl[lane] = __expf(-(bc + Mx));
            const float mnew = blast + fmaxf(m_prev, cml);
            wk[lane] = __expf(blast + u - mnew);
            if (lane == 0) { misc[0] = __expf(blast + m_prev - mnew); misc[1] = mnew; }
        }
        float kv[16], qv[16];
        {
            float rawk[19], rawq[19];
#pragma unroll
            for (int i = 0; i < 19; ++i) {
                rawk[i] = bf2f(Kraw[(16 * tqd + i) * 136 + k]);
                if (OUT) rawq[i] = bf2f(Qraw[(16 * tqd + i) * 136 + k]);
            }
#pragma unroll
            for (int i = 0; i < 16; ++i) {
                const float ak = cbk + cwk[0] * rawk[i] + cwk[1] * rawk[i + 1] + cwk[2] * rawk[i + 2] + cwk[3] * rawk[i + 3];
                kv[i] = silu_fast(ak) * QSCALE;
                if (OUT) { const float aq = cbq + cwq[0] * rawq[i] + cwq[1] * rawq[i + 1] + cwq[2] * rawq[i + 2] + cwq[3] * rawq[i + 3]; qv[i] = silu_fast(aq); }
            }
        }
        __syncthreads();
        const float decay = misc[0], mnew_r = misc[1];
        {
            float kw[16]; float np = 0.f;
#pragma unroll
            for (int i = 0; i < 16; ++i) {
                const int t = 16 * tqd + i;
                if (OUT) { Qs[t * 136 + k] = f2bf(qv[i]); Ks[t * 136 + k] = f2bf(kv[i]); }
                kw[i] = kv[i] * wk[t]; np += kw[i];
            }
            u32x4 w0 = {pk2(kw[0], kw[1]), pk2(kw[2], kw[3]), pk2(kw[4], kw[5]), pk2(kw[6], kw[7])}, w1 = {pk2(kw[8], kw[9]), pk2(kw[10], kw[11]), pk2(kw[12], kw[13]), pk2(kw[14], kw[15])};
            *(u32x4*)(KwT + k * 72 + 16 * tqd) = w0; *(u32x4*)(KwT + k * 72 + 16 * tqd + 8) = w1;
            npart[tqd * 128 + k] = np;
#pragma unroll
            for (int i = 0; i < 4; ++i) { const int id = tl + 512 * i; *(u32x4*)(VTs + (id >> 3) * 72 + (id & 7) * 8) = vst[i]; }
        }
        __syncthreads();
        if (OUT) {
            u32x4 onesw = {0x3F803F80u, 0x3F803F80u, 0x3F803F80u, 0x3F803F80u};
            const bf16x8 ONES = __builtin_bit_cast(bf16x8, onesw);
#pragma unroll 1
            for (int tt = 0; tt < 2; ++tt) {
                f32x16 oi = zero16(), di = zero16();
                const float rA = rowA[32 * tt + r];
#pragma unroll
                for (int kt = 0; kt < 4; ++kt) {
                    { const bf16x8 Bc = pack8<0>(Ct[kt]);
                      const bf16x8 Bn = join4(*(const s16x4*)(n16 + 32 * kt + 4 * h), *(const s16x4*)(n16 + 32 * kt + 8 + 4 * h));
                      const bf16x8 A = join4(*(const s16x4*)(Qs + (32 * tt + r) * 136 + 32 * kt + 4 * h), *(const s16x4*)(Qs + (32 * tt + r) * 136 + 32 * kt + 8 + 4 * h));
                      oi = MFMA32(A, Bc, oi); di = MFMA32(A, Bn, di); }
                    { const bf16x8 Bc = pack8<8>(Ct[kt]);
                      const bf16x8 Bn = join4(*(const s16x4*)(n16 + 32 * kt + 16 + 4 * h), *(const s16x4*)(n16 + 32 * kt + 24 + 4 * h));
                      const bf16x8 A = join4(*(const s16x4*)(Qs + (32 * tt + r) * 136 + 32 * kt + 16 + 4 * h), *(const s16x4*)(Qs + (32 * tt + r) * 136 + 32 * kt + 24 + 4 * h));
                      oi = MFMA32(A, Bc, oi); di = MFMA32(A, Bn, di); }
                }
#pragma unroll
                for (int gg = 0; gg < 4; ++gg) {
                    const f32x4 si = *(const f32x4*)(sint + 32 * tt + 8 * gg + 4 * h);
#pragma unroll
                    for (int i = 0; i < 4; ++i) { oi[4 * gg + i] *= si[i]; di[4 * gg + i] *= si[i]; }
                }
#pragma unroll
                for (int st = 0; st < 2; ++st) if (st <= tt) {
                    const s16x4 vp00 = *(const s16x4*)(vrow + 32 * st + 4 * h), vp01 = *(const s16x4*)(vrow + 32 * st + 8 + 4 * h);
                    const s16x4 vp10 = *(const s16x4*)(vrow + 32 * st + 16 + 4 * h), vp11 = *(const s16x4*)(vrow + 32 * st + 24 + 4 * h);
                    f32x16 a = zero16();
#pragma unroll
                    for (int ks = 0; ks < 8; ++ks) { const bf16x8 A = *(const bf16x8*)(Ks + (32 * st + r) * 136 + 16 * ks + 8 * h), B = *(const bf16x8*)(Qs + (32 * tt + r) * 136 + 16 * ks + 8 * h); a = MFMA32(A, B, a); }
#pragma unroll
                    for (int gg = 0; gg < 4; ++gg) { const f32x4 uu = *(const f32x4*)(uS + 32 * st + 8 * gg + 4 * h);
#pragma unroll
                        for (int i = 0; i < 4; ++i) { float w = __expf(rA + uu[i]); if (st == tt && (8 * gg + 4 * h + i) > r) w = 0.f; a[4 * gg + i] *= w; } }
                    const bf16x8 PA0 = pack8<0>(a), PA1 = pack8<8>(a);
                    oi = MFMA32(PA0, join4(vp00, vp01), oi); oi = MFMA32(PA1, join4(vp10, vp11), oi);
                    di = MFMA32(PA0, ONES, di); di = MFMA32(PA1, ONES, di);
                }
#pragma unroll
                for (int gg = 0; gg < 4; ++gg) {
                    const f32x4 nf4 = *(const f32x4*)(nfl + 32 * tt + 8 * gg + 4 * h);
#pragma unroll
                    for (int i = 0; i < 4; ++i)
                        Ost[(32 * tt + 8 * gg + 4 * h + i) * 260 + 32 * wid + r] = oi[4 * gg + i] * frcp(fmaxf(fabsf(di[4 * gg + i]), nf4[i]));
                }
            }
        }
        bf16x8 vn[4];
#pragma unroll
        for (int q4 = 0; q4 < 4; ++q4) vn[q4] = *(const bf16x8*)(vrow + 16 * q4 + 8 * h);
#pragma unroll
        for (int kt = 0; kt < 4; ++kt) {
#pragma unroll
            for (int rg = 0; rg < 16; ++rg) Ct[kt][rg] *= decay;
#pragma unroll
            for (int q4 = 0; q4 < 4; ++q4) { const bf16x8 A = *(const bf16x8*)(KwT + (32 * kt + r) * 72 + 16 * q4 + 8 * h); Ct[kt] = MFMA32(A, vn[q4], Ct[kt]); }
        }
        if (OUT) {
            __syncthreads();
            if (c < 7) {
                const int s1 = s0 + 64;
#pragma unroll
                for (int i = 0; i < 3; ++i) { const int id = tl + 512 * i; const int rr = id < 1072 ? (id >> 4) : 0, c16 = id & 15;
                    const size_t go = ((size_t)b * SEQ + (s1 - 3 + rr)) * 512 + head * 128 + c16 * 8;
                    kpre[i] = *(const u32x4*)(MK + go); qpre[i] = *(const u32x4*)(MQ + go); }
            }
            const int t = tl >> 3, seg = tl & 7;
            const size_t row = rowbase + t; const int col = head * 256 + 32 * seg;
            u32x4 mo[4], mz[4]; f32x4 gng[4][2];
#pragma unroll
            for (int i = 0; i < 4; ++i) { mo[i] = *(const u32x4*)(MO + row * 1024 + col + 8 * i); mz[i] = *(const u32x4*)(MZ + row * 1024 + col + 8 * i);
                gng[i][0] = *(const f32x4*)(gnl + 32 * seg + 8 * i); gng[i][1] = *(const f32x4*)(gnl + 32 * seg + 8 * i + 4); }
            float ss = 0.f;
#pragma unroll
            for (int i = 0; i < 4; ++i) {
                const f32x4 x0 = *(const f32x4*)(Ost + t * 260 + 32 * seg + 8 * i), x1 = *(const f32x4*)(Ost + t * 260 + 32 * seg + 8 * i + 4);
                const float y0 = x0[0] * bflo(mo[i][0]), y1 = x0[1] * bfhi(mo[i][0]), y2 = x0[2] * bflo(mo[i][1]), y3 = x0[3] * bfhi(mo[i][1]);
                const float y4 = x1[0] * bflo(mo[i][2]), y5 = x1[1] * bfhi(mo[i][2]), y6 = x1[2] * bflo(mo[i][3]), y7 = x1[3] * bfhi(mo[i][3]);
                ss += y0 * y0 + y1 * y1 + y2 * y2 + y3 * y3 + y4 * y4 + y5 * y5 + y6 * y6 + y7 * y7;
            }
            ss = xsum<1>(ss); ss = xsum<2>(ss); ss = xsum<4>(ss);
            const float rs = rsqrtf(ss * (1.f / 256.f) + 1e-6f);
#pragma unroll
            for (int i = 0; i < 4; ++i) {
                const f32x4 x0 = *(const f32x4*)(Ost + t * 260 + 32 * seg + 8 * i), x1 = *(const f32x4*)(Ost + t * 260 + 32 * seg + 8 * i + 4);
                const f32x4 g0 = gng[i][0], g1 = gng[i][1];
                u32x4 w;
                w.x = pk2(x0[0] * bflo(mo[i][0]) * rs * g0[0] * bflo(mz[i][0]), x0[1] * bfhi(mo[i][0]) * rs * g0[1] * bfhi(mz[i][0]));
                w.y = pk2(x0[2] * bflo(mo[i][1]) * rs * g0[2] * bflo(mz[i][1]), x0[3] * bfhi(mo[i][1]) * rs * g0[3] * bfhi(mz[i][1]));
                w.z = pk2(x1[0] * bflo(mo[i][2]) * rs * g1[0] * bflo(mz[i][2]), x1[1] * bfhi(mo[i][2]) * rs * g1[1] * bfhi(mz[i][2]));
                w.w = pk2(x1[2] * bflo(mo[i][3]) * rs * g1[2] * bflo(mz[i][3]), x1[3] * bfhi(mo[i][3]) * rs * g1[3] * bfhi(mz[i][3]));
                *(u32x4*)(p.M + row * 1024 + col + 8 * i) = w;
            }
        }
        if (tid < 128) { const float nv = decay * nf[tid] + npart[tid] + npart[128 + tid] + npart[256 + tid] + npart[384 + tid]; nf[tid] = nv; n16[tid] = f2bf(nv); }
        m_prev = mnew_r;
        if (OUT) __syncthreads();
    }
    if (!OUT) {
        const int slot = bh * 16 + j;
        float* dst = p.MS + (size_t)slot * 32768;
#pragma unroll
        for (int kt = 0; kt < 4; ++kt)
#pragma unroll
            for (int q4 = 0; q4 < 4; ++q4) { f32x4 t4 = {Ct[kt][4 * q4], Ct[kt][4 * q4 + 1], Ct[kt][4 * q4 + 2], Ct[kt][4 * q4 + 3]};
                *(f32x4*)(dst + ((wid * 4 + kt) * 4 + q4) * 256 + lane * 4) = t4; }
        __syncthreads();
        if (tid < 128) p.MN[(size_t)slot * 128 + tid] = nf[tid];
        if (tid == 0) { float bs = 0.f; for (int w8 = 0; w8 < 8; ++w8) bs += misc[4 + w8]; p.MSC[slot * 2] = m_prev; p.MSC[slot * 2 + 1] = bs; }
    }
    __syncthreads();
}

DI void mlstm_scan(const Params& p) {
    constexpr int PERQ = 8192 + 32;
    for (int e = blockIdx.x * 512 + ltid(); e < 16 * PERQ; e += gridDim.x * 512) {
        const int bh = e / PERQ, idx = e % PERQ;
        f32x4 u[15]; float ca[15], cb[15];
        float m = 0.f;
#pragma unroll
        for (int j = 0; j < 15; ++j) {
            const int slot = bh * 16 + j;
            u[j] = idx < 8192 ? *(const f32x4*)(p.MS + (size_t)slot * 32768 + idx * 4) : *(const f32x4*)(p.MN + (size_t)slot * 128 + (idx - 8192) * 4);
            const float mu = p.MSC[slot * 2], Bs = p.MSC[slot * 2 + 1];
            const float mn = fmaxf(Bs + m, mu);
            ca[j] = __expf(Bs + m - mn); cb[j] = __expf(mu - mn); m = mn;
            if (idx == 0) p.MM[slot] = mn;
        }
        f32x4 s = {0.f, 0.f, 0.f, 0.f};
#pragma unroll
        for (int j = 0; j < 15; ++j) { s = s * ca[j] + u[j] * cb[j]; u[j] = s; }
#pragma unroll
        for (int j = 0; j < 15; ++j) {
            const int slot = bh * 16 + j;
            if (idx < 8192) *(f32x4*)(p.MS + (size_t)slot * 32768 + idx * 4) = u[j]; else *(f32x4*)(p.MN + (size_t)slot * 128 + (idx - 8192) * 4) = u[j];
        }
    }
}

#define XB_TMO      128
#define XB_XCNT(j)  (256  + 64 * (j))
#define XB_XSUB(j)  (1280 + 64 * (j))
#define XB_XGEN(j)  (2304 + 64 * (j))
#define XB_TOP      3328
#define XB_TOPGEN   3392
#define XCD_BAR_WORDS 3456
#define XB_SPIN_CAP (1u << 18)
DI unsigned xb_ld(unsigned* p)              { return __hip_atomic_load(p, __ATOMIC_RELAXED, __HIP_MEMORY_SCOPE_AGENT); }
DI unsigned xb_add(unsigned* p, unsigned v) { return __hip_atomic_fetch_add(p, v, __ATOMIC_RELAXED, __HIP_MEMORY_SCOPE_AGENT); }
DI unsigned xb_xcc_id() { return (unsigned)__builtin_amdgcn_s_getreg((3 << 11) | 20) & 0xFu; }
#define XB_SPIN(cond, bar) do { unsigned _sp = 0; while (cond) { __builtin_amdgcn_s_sleep(1); \
    if ((++_sp & 255u) == 0u) { if (xb_ld(&(bar)[XB_TMO])) break; if (_sp > XB_SPIN_CAP) { atomicAdd(&(bar)[XB_TMO], 1u); break; } } } } while (0)
struct XcdBarrier { unsigned* bar; unsigned x; volatile LAS unsigned* st; };
DI XcdBarrier xcd_barrier_post(unsigned* bar, volatile LAS unsigned* st) {
    XcdBarrier b; b.bar = bar; b.x = xb_xcc_id(); b.st = st;
    if (threadIdx.x == 0) (void)xb_add(&bar[XB_XCNT(b.x)], 1u);
    return b;
}
DI void xcd_barrier_complete(unsigned* bar, unsigned x, unsigned& nloc, unsigned& nx) {
    const unsigned G = gridDim.x * gridDim.y * gridDim.z;
    unsigned sum, cnt, mine, sp = 0u;
    for (;;) {
        sum = 0u; cnt = 0u; mine = 0u;
#pragma unroll
        for (unsigned j = 0; j < 16; ++j) { const unsigned c = xb_ld(&bar[XB_XCNT(j)]); sum += c; cnt += (c > 0u) ? 1u : 0u; mine = (j == x) ? c : mine; }
        if (sum == G) break;
        __builtin_amdgcn_s_sleep(1);
        if ((++sp & 255u) == 0u) { if (xb_ld(&bar[XB_TMO])) break; if (sp > XB_SPIN_CAP) { atomicAdd(&bar[XB_TMO], 1u); break; } }
    }
    nloc = mine > 0u ? mine : 1u; nx = cnt > 0u ? cnt : 1u;
}
DI void xcd_barrier(const XcdBarrier& b) {
    asm volatile("s_waitcnt vmcnt(0)" ::: "memory");
    __syncthreads();
    if (threadIdx.x == 0) {
        unsigned* bar = b.bar;
        __builtin_amdgcn_s_waitcnt(0);
        unsigned nloc = b.st[0], nx = b.st[1];
        if (nloc == 0u) { xcd_barrier_complete(bar, b.x, nloc, nx); b.st[0] = nloc; b.st[1] = nx; }
        const unsigned old = xb_add(&bar[XB_XSUB(b.x)], 1u);
        const unsigned gen = old / nloc;
        if (old + 1u == (gen + 1u) * nloc) {
            __builtin_amdgcn_fence(__ATOMIC_RELEASE, "agent");
            asm volatile("s_waitcnt vmcnt(0)" ::: "memory");
            const unsigned og = xb_add(&bar[XB_TOP], 1u);
            const unsigned tg = og / nx;
            if (og + 1u == (tg + 1u) * nx) xb_add(&bar[XB_TOPGEN], 1u);
            else XB_SPIN(xb_ld(&bar[XB_TOPGEN]) == tg, bar);
            __builtin_amdgcn_fence(__ATOMIC_ACQUIRE, "agent");
            xb_add(&bar[XB_XGEN(b.x)], 1u);
            asm volatile("s_waitcnt vmcnt(0)" ::: "memory");
        } else {
            XB_SPIN(xb_ld(&bar[XB_XGEN(b.x)]) == gen, bar);
            __builtin_amdgcn_fence(__ATOMIC_ACQUIRE, "agent");
            asm volatile("s_waitcnt vmcnt(0)" ::: "memory");
        }
    }
    __syncthreads();
}

#ifndef REP_A
#define REP_A 1
#endif
#ifndef REP_B
#define REP_B 1
#endif
#ifndef REP_C
#define REP_C 1
#endif
#ifndef REP_FOX
#define REP_FOX 1
#endif
#ifndef REP_HGC
#define REP_HGC 1
#endif
#ifndef REP_MLC
#define REP_MLC 1
#endif
#ifndef REP_S
#define REP_S 1
#endif
#define GSYNC() do { for (int _s = 0; _s < REP_S; ++_s) xcd_barrier(xb); } while (0)
__global__ void __launch_bounds__(512, 2) mega(Params p) {
    extern __shared__ __attribute__((aligned(16))) unsigned char shm[];
    cg::grid_group grid = cg::this_grid();
    const int G = gridDim.x, bid = blockIdx.x;
    volatile LAS unsigned* xst = (volatile LAS unsigned*)((LAS unsigned char*)shm + (LDS_BYTES - 16));
    if (threadIdx.x == 0) { xst[0] = 0u; xst[1] = 0u; }
    __syncthreads();
    const XcdBarrier xb = xcd_barrier_post(p.bar, xst);
    if (p.never) grid.sync();
    for (int rep = 0; rep < REP_C; ++rep) { phase_prep(p, shm); GSYNC(); }
    for (int rep = 0; rep < REP_C; ++rep) { pg8::StaticOrder S; S.init(T, 4096, G, bid); pg8::Gemm g{p.X16, p.W0T, T, 4096, 1024}; EpiIn0 E{p.P, p.LB, p.QKM}; pg8::gemm_phase(( LAS unsigned char*)shm, g, S, E); GSYNC(); }
    for (int rep = 0; rep < REP_A; ++rep) { for (int it = bid; it < 256; it += G) hgrn_item<false>(p, it, shm);
    phase_foxprep(p, shm);
    GSYNC(); }
    hgrn_scan(p);
    for (int rep = 0; rep < REP_FOX; ++rep) { for (int it = bid; it < 512; it += G) fox_item(p, it, shm);
    GSYNC(); }
    for (int rep = 0; rep < REP_HGC; ++rep) { for (int it = bid; it < 256; it += G) hgrn_item<true>(p, it, shm);
    GSYNC(); }
    { pg8::StaticOrder S; S.init(T, 1024, G, bid); pg8::Gemm g{p.M, p.W0oT, T, 1024, 1024}; EpiOut<true> E{p.X16, p.out}; pg8::gemm_phase((LAS unsigned char*)shm, g, S, E); }
    GSYNC();
    phase_ln<true>(p, 0, shm);
    GSYNC();
    { pg8::StaticOrder S; S.init(T, 4096, G, bid); pg8::Gemm g{p.X16, p.W1T, T, 4096, 1024}; EpiIn1 E{p.P}; pg8::gemm_phase((LAS unsigned char*)shm, g, S, E); }
    GSYNC();
    for (int rep = 0; rep < REP_B; ++rep) { for (int it = bid; it < 256; it += G) mlstm_item<false>(p, it, shm);
    GSYNC(); }
    mlstm_scan(p);
    GSYNC();
    for (int rep = 0; rep < REP_MLC; ++rep) { for (int it = bid; it < 256; it += G) mlstm_item<true>(p, it, shm);
    GSYNC(); }
    { pg8::StaticOrder S; S.init(T, 1024, G, bid); pg8::Gemm g{p.M, p.W1oT, T, 1024, 1024}; EpiOut<false> E{p.X16, p.out}; pg8::gemm_phase((LAS unsigned char*)shm, g, S, E); }
    GSYNC();
    phase_ln<false>(p, 1, shm);
}

extern "C" void kernel_launch(void* const* d_in, const int* in_sizes, int n_in, void* d_out, int out_size, void* d_ws, size_t ws_size, hipStream_t stream) {
    static int grid_blocks = 0;
    if (!grid_blocks) {
        int dev = 0, cus = 0, per_cu = 0;
        hipGetDevice(&dev);
        hipDeviceGetAttribute(&cus, hipDeviceAttributeMultiprocessorCount, dev);
        hipFuncSetAttribute((const void*)mega, hipFuncAttributeMaxDynamicSharedMemorySize, LDS_BYTES);
        hipOccupancyMaxActiveBlocksPerMultiprocessor(&per_cu, mega, 512, LDS_BYTES);
        if (per_cu < 1) per_cu = 1;
        if (per_cu > 1) per_cu = 1;
        grid_blocks = cus * per_cu;
    }
    Params p{};
    p.x = (const float*)d_in[0]; p.lb_logits = (const float*)d_in[1]; p.ab_w_in = (const float*)d_in[2]; p.ab_fox_bf = (const float*)d_in[3];
    p.ab_norm_g = (const float*)d_in[4]; p.ab_w_out = (const float*)d_in[5]; p.c_w_in = (const float*)d_in[6]; p.c_conv_w = (const float*)d_in[7];
    p.c_conv_b = (const float*)d_in[8]; p.c_bi = (const float*)d_in[9]; p.c_bf = (const float*)d_in[10]; p.c_norm_g = (const float*)d_in[11];
    p.c_w_out = (const float*)d_in[12]; p.ln_g = (const float*)d_in[13]; p.ln_b = (const float*)d_in[14];
    p.out = (float*)d_out;
    unsigned char* w = (unsigned char*)d_ws;
    const size_t MiB = 1048576;
    p.W0T = (u16*)(w); p.W1T = (u16*)(w + 8 * MiB); p.W0oT = (u16*)(w + 16 * MiB); p.W1oT = (u16*)(w + 18 * MiB);
    p.X16 = (u16*)(w + 20 * MiB);
    p.P = (u16*)(w + 84 * MiB);
    p.M = (u16*)(w + 340 * MiB);
    unsigned char* sm = w + 404 * MiB;
    p.LF = (float*)(sm); p.CS = (float*)(sm + 1 * MiB); p.IG = (float*)(sm + 2 * MiB); p.FG = (float*)(sm + 3 * MiB);
    p.LB = (float*)(sm + 4 * MiB); p.QKM = (unsigned*)(sm + 4 * MiB + 4096);
    p.MSC = (float*)(sm + 4 * MiB + 8192); p.MM = (float*)(sm + 4 * MiB + 16384);
    p.bar = (unsigned*)(sm + 5 * MiB); p.never = 0; p.pad_ = 0;
    p.HS = (float*)(w + 416 * MiB); p.HD = (float*)(w + 416 * MiB + 32 * MiB);
    p.MS = (float*)(w + 416 * MiB); p.MN = (float*)(w + 416 * MiB + 32 * MiB);
    if (ws_size < 450 * MiB) { fprintf(stderr, "workspace too small: %zu\n", ws_size); return; }
    (void)hipMemsetAsync(p.bar, 0, XCD_BAR_WORDS * sizeof(unsigned), stream);
    void* args[] = {&p};
    hipError_t e = hipLaunchCooperativeKernel((const void*)mega, dim3(grid_blocks), dim3(512), args, LDS_BYTES, stream);
    if (e != hipSuccess) fprintf(stderr, "cooperative launch failed: %s (grid %d)\n", hipGetErrorString(e), grid_blocks);
}
```
